# Optimizing an MI355X kernel written in HIP

```python
import math
import jax
import jax.numpy as jnp
from jax import lax
import numpy as np

D_MODEL = 1024
BATCH = 8
SEQ = 4096
DEPTH = 2

HEAD_DIM = 64
ROT_DIM = HEAD_DIM // 4
ROPE_THETA = 500000.0
A_GROUPS = ((128, 1), (512, 4), (2048, 16))
A_HEADS = 8
B_HEADS = D_MODEL // (2 * HEAD_DIM)
D_FF = ((8 * D_MODEL // 3 + 255) // 256) * 256
CONV_WIDTH = 3
Q_BLOCK = 128
N_A_LAYERS = DEPTH // 2
N_B_LAYERS = DEPTH - N_A_LAYERS
NORM_EPS = 1e-6
SUBLN_EPS = 1e-5
NEG_INF = -1e30

kernel_name = "yoco_dilated_diffattn_convffn_block"


def rms_norm(x, g, eps=NORM_EPS):
    x32 = x.astype(jnp.float32)
    y = x32 * lax.rsqrt(jnp.mean(x32 * x32, axis=-1, keepdims=True) + eps)
    return (y * g.astype(jnp.float32)).astype(x.dtype)


def ada_mod(c_act, w, b, n):
    m = c_act @ w + b
    return jnp.split(m[:, None, :], n, axis=-1)


def rope_tables(positions):
    inv = jnp.power(ROPE_THETA, -jnp.arange(0, ROT_DIM, 2, dtype=jnp.float32) / ROT_DIM)
    ang = positions.astype(jnp.float32)[..., None] * inv
    return jnp.cos(ang), jnp.sin(ang)


def apply_partial_rope(x, cos, sin):
    extra = x.ndim - 3
    shp = cos.shape[:2] + (1,) * extra + cos.shape[-1:]
    cos = cos.reshape(shp).astype(x.dtype)
    sin = sin.reshape(shp).astype(x.dtype)
    half = ROT_DIM // 2
    x1 = x[..., :half]
    x2 = x[..., half:ROT_DIM]
    return jnp.concatenate([x1 * cos - x2 * sin, x2 * cos + x1 * sin, x[..., ROT_DIM:]], axis=-1)


def dilated_window_attention(q, k, v, window, dilation):
    B, S, H, Dh = q.shape
    L = S // dilation
    W = window // dilation
    nb = -(-L // W)
    Lp = nb * W

    def by_residue(t):
        return t.reshape(B, L, dilation, H, Dh).transpose(0, 2, 1, 3, 4)

    qr, kr, vr = by_residue(q), by_residue(k), by_residue(v)
    qb = jnp.pad(qr, ((0, 0), (0, 0), (0, Lp - L), (0, 0), (0, 0))).reshape(B, dilation, nb, W, H, Dh)

    def kv_blocks(t):
        tb = jnp.pad(t, ((0, 0), (0, 0), (W, Lp - L), (0, 0), (0, 0))).reshape(B, dilation, nb + 1, W, H, Dh)
        return jnp.concatenate([tb[:, :, :-1], tb[:, :, 1:]], axis=3)

    kb, vb = kv_blocks(kr), kv_blocks(vr)
    i = jnp.arange(W)[:, None]
    j = jnp.arange(2 * W)[None, :]
    n = jnp.arange(nb)[:, None, None]
    delta = W + i - j
    mask = (delta >= 0) & (delta <= W) & (n * W + j - W >= 0)

    s = jnp.einsum('brnqhd,brnkhd->brnhqk', qb, kb).astype(jnp.float32) * (Dh ** -0.5)
    s = jnp.where(mask[None, None, :, None], s, NEG_INF)
    mx = jnp.max(s, axis=-1, keepdims=True)
    p = jnp.exp(s - mx)
    den = jnp.sum(p, axis=-1)
    o = jnp.einsum('brnhqk,brnkhd->brnqhd', p.astype(v.dtype), vb).astype(jnp.float32)
    o = o / jnp.transpose(den, (0, 1, 2, 4, 3))[..., None]
    lse = jnp.transpose(mx[..., 0] + jnp.log(den), (0, 1, 2, 4, 3))

    def back(t):
        t = t.reshape((B, dilation, Lp) + t.shape[4:])[:, :, :L]
        t = jnp.moveaxis(t, 1, 2)
        return t.reshape((B, S) + t.shape[3:])

    return back(o), back(lse)


def dilated_mixer(h, w_qkv, w_o, cos, sin):
    B, S, _ = h.shape
    qkv = (h @ w_qkv).reshape(B, S, len(A_GROUPS), 3, A_HEADS, HEAD_DIM)
    outs, lses = [], []
    for g, (window, dil) in enumerate(A_GROUPS):
        q = apply_partial_rope(qkv[:, :, g, 0], cos, sin)
        k = apply_partial_rope(qkv[:, :, g, 1], cos, sin)
        o, lse = dilated_window_attention(q, k, qkv[:, :, g, 2], window, dil)
        outs.append(o)
        lses.append(lse)
    o = jnp.stack(outs, axis=0)
    alpha = jax.nn.softmax(jnp.stack(lses, axis=0), axis=0)
    mixed = jnp.sum(alpha[..., None] * o, axis=0)
    return mixed.reshape(B, S, A_HEADS * HEAD_DIM).astype(h.dtype) @ w_o


def shared_kv(x, c_act, kv_norm, kv_mod_w, kv_mod_b, w_k, w_v, cos, sin):
    B, S, _ = x.shape
    shift, scale = ada_mod(c_act, kv_mod_w, kv_mod_b, 2)
    hk = rms_norm(x, kv_norm) * (1.0 + scale) + shift
    k = apply_partial_rope((hk @ w_k).reshape(B, S, B_HEADS, 2, HEAD_DIM), cos, sin)
    v = (hk @ w_v).reshape(B, S, B_HEADS, 2 * HEAD_DIM)
    return k, v


def diff_attention(q, k, v, lam):
    B, S, H, _, Dh = q.shape
    nq = S // Q_BLOCK
    qb = q.reshape(B, nq, Q_BLOCK, H, 2, Dh).transpose(1, 0, 2, 3, 4, 5)
    kpos = jnp.arange(S)
    scale = Dh ** -0.5

    def one_block(args):
        qi, bi = args
        s = jnp.einsum('bqhcd,bkhcd->bhcqk', qi, k).astype(jnp.float32) * scale
        qpos = bi * Q_BLOCK + jnp.arange(Q_BLOCK)
        s = jnp.where((kpos[None, :] <= qpos[:, None])[None, None, None], s, NEG_INF)
        p = jax.nn.softmax(s, axis=-1)
        a = p[:, :, 0] - lam * p[:, :, 1]
        return jnp.einsum('bhqk,bkhe->bqhe', a.astype(v.dtype), v)

    o = lax.map(one_block, (qb, jnp.arange(nq)))
    return o.transpose(1, 0, 2, 3, 4).reshape(B, S, H, 2 * Dh)


def diff_mixer(h, k, v, w_q, lq1, lk1, lq2, lk2, subln, w_o, lam_init, cos, sin):
    B, S, _ = h.shape
    q = apply_partial_rope((h @ w_q).reshape(B, S, B_HEADS, 2, HEAD_DIM), cos, sin)
    f32 = jnp.float32
    lam = (jnp.exp(jnp.sum(lq1.astype(f32) * lk1.astype(f32)))
           - jnp.exp(jnp.sum(lq2.astype(f32) * lk2.astype(f32))) + lam_init)
    o = diff_attention(q, k, v, lam)
    o = rms_norm(o, subln, eps=SUBLN_EPS) * (1.0 - lam_init)
    return o.reshape(B, S, B_HEADS * 2 * HEAD_DIM) @ w_o


def conv_ffn(h, w_gate, w_up, conv_w, conv_b, w_down):
    S = h.shape[1]
    a = h @ w_gate
    ap = jnp.pad(a, ((0, 0), (CONV_WIDTH - 1, 0), (0, 0)))
    conv = conv_b
    for t in range(CONV_WIDTH):
        conv = conv + conv_w[t] * ap[:, t:t + S]
    return (jax.nn.gelu(conv, approximate=True) * (h @ w_up)) @ w_down


def setup_inputs(seed: int = 0) -> dict:
    key = jax.random.key(seed)
    ks = jax.random.split(key, 32)
    f32 = jnp.float32
    D, F = D_MODEL, D_FF
    G = len(A_GROUPS)
    a_inner = A_HEADS * HEAD_DIM
    b_inner = B_HEADS * 2 * HEAD_DIM

    def w(k, shape, fan_in, gain=1.0):
        return jax.random.normal(k, shape, f32) * (gain * fan_in ** -0.5)

    def gain(k, shape):
        return 1.0 + 0.05 * jax.random.normal(k, shape, f32)

    def bias(k, shape):
        return 0.01 * jax.random.normal(k, shape, f32)

    positions = (jnp.arange(SEQ, dtype=jnp.int32)[None, :]
                 + jax.random.randint(ks[2], (BATCH, 1), 0, 2048, dtype=jnp.int32))
    return {
        'x': jax.random.normal(ks[0], (BATCH, SEQ, D), f32),
        'c': jax.random.normal(ks[1], (BATCH, D), f32),
        'positions': positions,
        'mod_mix_w': w(ks[3], (DEPTH, D, 3 * D), D, 0.5),
        'mod_mix_b': bias(ks[4], (DEPTH, 3 * D)),
        'mod_ffn_w': w(ks[5], (DEPTH, D, 3 * D), D, 0.5),
        'mod_ffn_b': bias(ks[6], (DEPTH, 3 * D)),
        'norm_pre_mix': gain(ks[7], (DEPTH, D)),
        'norm_post_mix': gain(ks[8], (DEPTH, D)),
        'norm_pre_ffn': gain(ks[9], (DEPTH, D)),
        'norm_post_ffn': gain(ks[10], (DEPTH, D)),
        'ffn_w_gate': w(ks[11], (DEPTH, D, F), D),
        'ffn_w_up': w(ks[12], (DEPTH, D, F), D),
        'ffn_conv_w': w(ks[13], (DEPTH, CONV_WIDTH, F), CONV_WIDTH),
        'ffn_conv_b': bias(ks[14], (DEPTH, F)),
        'ffn_w_down': w(ks[15], (DEPTH, F, D), F),
        'a_w_qkv': w(ks[16], (N_A_LAYERS, D, G * 3 * a_inner), D),
        'a_w_o': w(ks[17], (N_A_LAYERS, a_inner, D), a_inner),
        'kv_norm': gain(ks[18], (D,)),
        'kv_mod_w': w(ks[19], (D, 2 * D), D, 0.5),
        'kv_mod_b': bias(ks[20], (2 * D,)),
        'b_w_k': w(ks[21], (D, b_inner), D),
        'b_w_v': w(ks[22], (D, b_inner), D),
        'b_w_q': w(ks[23], (N_B_LAYERS, D, b_inner), D),
        'b_lambda_q1': 0.1 * jax.random.normal(ks[24], (N_B_LAYERS, HEAD_DIM), f32),
        'b_lambda_k1': 0.1 * jax.random.normal(ks[25], (N_B_LAYERS, HEAD_DIM), f32),
        'b_lambda_q2': 0.1 * jax.random.normal(ks[26], (N_B_LAYERS, HEAD_DIM), f32),
        'b_lambda_k2': 0.1 * jax.random.normal(ks[27], (N_B_LAYERS, HEAD_DIM), f32),
        'b_subln': gain(ks[28], (N_B_LAYERS, 2 * HEAD_DIM)),
        'b_w_o': w(ks[29], (N_B_LAYERS, b_inner, D), b_inner),
    }


def reference(x, c, positions, mod_mix_w, mod_mix_b, mod_ffn_w, mod_ffn_b,
              norm_pre_mix, norm_post_mix, norm_pre_ffn, norm_post_ffn,
              ffn_w_gate, ffn_w_up, ffn_conv_w, ffn_conv_b, ffn_w_down,
              a_w_qkv, a_w_o, kv_norm, kv_mod_w, kv_mod_b, b_w_k, b_w_v,
              b_w_q, b_lambda_q1, b_lambda_k1, b_lambda_q2, b_lambda_k2, b_subln, b_w_o):
    c_act = jax.nn.silu(c)
    cos, sin = rope_tables(positions)
    k_sh, v_sh = None, None
    for l in range(DEPTH):
        shift, scale, gate = ada_mod(c_act, mod_mix_w[l], mod_mix_b[l], 3)
        if l == N_A_LAYERS:
            k_sh, v_sh = shared_kv(x, c_act, kv_norm, kv_mod_w, kv_mod_b, b_w_k, b_w_v, cos, sin)
        h = rms_norm(x, norm_pre_mix[l]) * (1.0 + scale) + shift
        if l < N_A_LAYERS:
            y = dilated_mixer(h, a_w_qkv[l], a_w_o[l], cos, sin)
        else:
            j = l - N_A_LAYERS
            lam_init = 0.8 - 0.6 * math.exp(-0.3 * l)
            y = diff_mixer(h, k_sh, v_sh, b_w_q[j], b_lambda_q1[j], b_lambda_k1[j],
                           b_lambda_q2[j], b_lambda_k2[j], b_subln[j], b_w_o[j], lam_init, cos, sin)
        x = x + gate * rms_norm(y, norm_post_mix[l])
        shift, scale, gate = ada_mod(c_act, mod_ffn_w[l], mod_ffn_b[l], 3)
        h = rms_norm(x, norm_pre_ffn[l]) * (1.0 + scale) + shift
        y = conv_ffn(h, ffn_w_gate[l], ffn_w_up[l], ffn_conv_w[l], ffn_conv_b[l], ffn_w_down[l])
        x = x + gate * rms_norm(y, norm_post_ffn[l])
    return x
```

```cpp
#include <hip/hip_runtime.h>
#include <hip/hip_cooperative_groups.h>
#include <cstdio>
#include <cstdint>
namespace cg = cooperative_groups;
constexpr float QSCALE = 0.125f * 1.4426950408889634f;
namespace pg8 {
#define PG8_LAS __attribute__((address_space(3)))
typedef unsigned short bf16_t;
typedef short bf16x8 __attribute__((ext_vector_type(8)));
typedef float f32x4 __attribute__((ext_vector_type(4)));
typedef unsigned u32x4 __attribute__((ext_vector_type(4)));
constexpr int BM = 256, BK = 64, HALF = 128, HTB = HALF * BK * 2  , STAGE_BYTES = 8 * HTB, NXCD = 8, WGM = 8;

__host__ __device__ __forceinline__ int lds_byte(int r, int c) { const int st = (r >> 4) * 2 + (c >> 5), rr = r & 15, cc = c & 31, ob = rr * 64 + cc * 2; return st * 1024 + (ob ^ (((ob >> 9) & 1) << 5)); }
__host__ __device__ __forceinline__ void stage_rc(int b, int& R, int& C) { const int st = b / 1024, sb = b % 1024, swz = sb ^ (((sb >> 9) & 1) << 5); R = (st >> 1) * 16 + swz / 64; C = (st & 1) * 32 + (swz % 64) / 2; }
__host__ __device__ __forceinline__ int perm32(int rho) { const int n = rho >> 4, i = rho & 15; return 8 * (i >> 2) + 4 * n + (i & 3); }

struct Unit { int pm, pn; };
struct Gemm { const bf16_t* A; const bf16_t* Bt; int M, N, K; };

struct StaticOrder {
    int nM, nN, nwg, G, c;
    __host__ __device__ void init(int M, int N, int G_, int c_) { nM = M / BM; nN = N / BM; nwg = nM * nN; G = G_; c = c_; }
    __host__ __device__ bool next(int i, Unit& u) const {
        const long L = (long)i * G + c; if (L >= nwg) return false;
        int wgid = (int)L; { const int q = nwg / NXCD, r = nwg % NXCD, xcd = wgid % NXCD, off = wgid / NXCD; wgid = (xcd < r ? xcd * (q + 1) : r * (q + 1) + (xcd - r) * q) + off; }
        const int nig = WGM * nN, gid = wgid / nig, fm = gid * WGM, gsz = (nM - fm) < WGM ? (nM - fm) : WGM;
        u.pm = fm + ((wgid % nig) % gsz); u.pn = (wgid % nig) / gsz; return true;
    }
    __device__ __forceinline__ void a_ready(const Unit&) const {}
    __device__ __forceinline__ void done(const Unit&) const {}
};
__device__ __forceinline__ unsigned cvt_pk_bf16(float lo, float hi) { unsigned r; asm volatile("v_cvt_pk_bf16_f32 %0, %1, %2" : "=v"(r) : "v"(lo), "v"(hi)); return r; }
typedef float f32x2 __attribute__((ext_vector_type(2)));
typedef unsigned u32x2 __attribute__((ext_vector_type(2)));
struct EpiBf16P {
    static constexpr bool PERM = true, AFTER_DRAIN = false;
    bf16_t* O; int ldc;
    __device__ __forceinline__ void operator()(const f32x4 (&acc)[2][2][4][2], const Unit& u, int wr, int wc, int fr, int fq) const {
        const int row0 = u.pm * BM + wr * 64 + fr, col0 = u.pn * BM + wc * 32 + 8 * fq;
#pragma unroll
        for (int ai = 0; ai < 2; ++ai)
#pragma unroll
            for (int m = 0; m < 4; ++m) { bf16_t* rowp = O + (size_t)(row0 + ai * HALF + m * 16) * ldc + col0;
#pragma unroll
                for (int bj = 0; bj < 2; ++bj) { const f32x4 v0 = acc[ai][bj][m][0], v1 = acc[ai][bj][m][1];
                    u32x4 w; w.x = cvt_pk_bf16(v0[0], v0[1]); w.y = cvt_pk_bf16(v0[2], v0[3]); w.z = cvt_pk_bf16(v1[0], v1[1]); w.w = cvt_pk_bf16(v1[2], v1[3]);
                    *(u32x4*)(rowp + bj * HALF) = w; } }
    }
};
template <int MODE> struct EpiRope {
    static constexpr bool PERM = true, AFTER_DRAIN = false;
    bf16_t* O; int ldc; const float* rope; size_t split_stride;
    __device__ __forceinline__ void operator()(const f32x4 (&acc)[2][2][4][2], const Unit& u, int wr, int wc, int fr, int fq) const {
        const int colt = u.pn * BM;
        bool rot = true; float sc = 1.f; int dil = 1; bf16_t* base = O; int ct = colt;
        if (MODE == 0) { const int g = colt / 1536, t = (colt % 1536) / 512; rot = t < 2; sc = (t == 0) ? QSCALE : 1.f; dil = (g == 0) ? 1 : (g == 1 ? 4 : 16); }
        else if (MODE == 1) { rot = colt < 1024; if (!rot) { base += split_stride; ct -= 1024; } }
        else { sc = QSCALE; }
        const int col0 = ct + wc * 32 + 8 * fq;
        const bool dorot = rot && ((wc & 1) == 0) && (fq < 2);
#pragma unroll
        for (int ai = 0; ai < 2; ++ai)
#pragma unroll
            for (int m = 0; m < 4; ++m) {
                const int row = u.pm * BM + ai * HALF + wr * 64 + m * 16 + fr;
                int orow = row;
                if (MODE == 0 && dil > 1) { const int b = row >> 12, s = row & 4095; orow = (b << 12) + (s % dil) * (4096 / dil) + s / dil; }
                f32x4 cs0 = (f32x4){1.f, 0.f, 1.f, 0.f}, cs1 = (f32x4){1.f, 0.f, 1.f, 0.f};
                if (dorot) { const f32x4* rp = (const f32x4*)(rope + (size_t)row * 16 + fq * 8); cs0 = rp[0]; cs1 = rp[1]; }
                bf16_t* rowp = base + (size_t)orow * ldc + col0;
#pragma unroll
                for (int bj = 0; bj < 2; ++bj) { f32x4 v0 = acc[ai][bj][m][0], v1 = acc[ai][bj][m][1];
                    if (dorot) {
                        const f32x4 a = v0, b = v1;
                        v0[0] = a[0] * cs0[0] - a[1] * cs0[1]; v0[1] = a[1] * cs0[0] + a[0] * cs0[1];
                        v0[2] = a[2] * cs0[2] - a[3] * cs0[3]; v0[3] = a[3] * cs0[2] + a[2] * cs0[3];
                        v1[0] = b[0] * cs1[0] - b[1] * cs1[1]; v1[1] = b[1] * cs1[0] + b[0] * cs1[1];
                        v1[2] = b[2] * cs1[2] - b[3] * cs1[3]; v1[3] = b[3] * cs1[2] + b[2] * cs1[3];
                    }
                    v0 = v0 * sc; v1 = v1 * sc;
                    u32x4 w; w.x = cvt_pk_bf16(v0[0], v0[1]); w.y = cvt_pk_bf16(v0[2], v0[3]); w.z = cvt_pk_bf16(v1[0], v1[1]); w.w = cvt_pk_bf16(v1[2], v1[3]);
                    *(u32x4*)(rowp + bj * HALF) = w; }
            }
    }
};
struct EpiY {
    static constexpr bool PERM = false, AFTER_DRAIN = false;
    float* Y; int ldc; float* ssq;
    __device__ __forceinline__ void operator()(const f32x4 (&acc)[2][2][4][2], const Unit& u, int wr, int wc, int fr, int fq) const {
        const int col0 = u.pn * BM + wc * 32 + 4 * fq;
#pragma unroll
        for (int ai = 0; ai < 2; ++ai)
#pragma unroll
            for (int m = 0; m < 4; ++m) {
                const int row = u.pm * BM + ai * HALF + wr * 64 + m * 16 + fr;
                float* rowp = Y + (size_t)row * ldc + col0; float s = 0.f;
#pragma unroll
                for (int bj = 0; bj < 2; ++bj)
#pragma unroll
                    for (int n = 0; n < 2; ++n) { const f32x4 v = acc[ai][bj][m][n]; s += (v[0] * v[0] + v[1] * v[1]) + (v[2] * v[2] + v[3] * v[3]); *(f32x4*)(rowp + bj * HALF + n * 16) = v; }
                s += __shfl_xor(s, 16); s += __shfl_xor(s, 32);
                if (fq == 0) ssq[(size_t)row * 16 + u.pn * 4 + wc] = s;
            }
    }
};
struct EpiUpConv {
    static constexpr bool PERM = true, AFTER_DRAIN = false;
    const bf16_t* A; bf16_t* Fo; const float* cw; const float* cb; int ff;
    __device__ __forceinline__ void operator()(const f32x4 (&acc)[2][2][4][2], const Unit& u, int wr, int wc, int fr, int fq) const {
        const int row0 = u.pm * BM + wr * 64 + fr;
#pragma unroll
        for (int bj = 0; bj < 2; ++bj) {
            const int col = u.pn * BM + bj * HALF + wc * 32 + 8 * fq;
            float w0[8], w1[8], w2[8], bb[8];
#pragma unroll
            for (int h = 0; h < 2; ++h) { const f32x4 t0 = *(const f32x4*)(cw + col + 4 * h), t1 = *(const f32x4*)(cw + ff + col + 4 * h), t2 = *(const f32x4*)(cw + 2 * ff + col + 4 * h), t3 = *(const f32x4*)(cb + col + 4 * h);
#pragma unroll
                for (int e = 0; e < 4; ++e) { w0[4 * h + e] = t0[e]; w1[4 * h + e] = t1[e]; w2[4 * h + e] = t2[e]; bb[4 * h + e] = t3[e]; } }
#pragma unroll
            for (int ai = 0; ai < 2; ++ai)
#pragma unroll
                for (int m = 0; m < 4; ++m) {
                    const int row = row0 + ai * HALF + m * 16; const int s = row & 4095;
                    const bf16_t* ap = A + (size_t)row * ff + col;
                    const u32x4 z = (u32x4){0u, 0u, 0u, 0u};
                    const u32x4 a2 = *(const u32x4*)ap;
                    const u32x4 a1 = (s >= 1) ? *(const u32x4*)(ap - ff) : z;
                    const u32x4 a0 = (s >= 2) ? *(const u32x4*)(ap - 2 * ff) : z;
                    float f[8];
#pragma unroll
                    for (int e = 0; e < 8; ++e) {
                        const unsigned x0 = a0[e >> 1], x1 = a1[e >> 1], x2 = a2[e >> 1];
                        const float f0 = __uint_as_float((e & 1) ? (x0 & 0xffff0000u) : (x0 << 16));
                        const float f1 = __uint_as_float((e & 1) ? (x1 & 0xffff0000u) : (x1 << 16));
                        const float f2 = __uint_as_float((e & 1) ? (x2 & 0xffff0000u) : (x2 << 16));
                        const float cv = bb[e] + w0[e] * f0 + w1[e] * f1 + w2[e] * f2;
                        const float zz = 1.5957691216057308f * (cv + 0.044715f * cv * cv * cv);
                        const float ex = __builtin_amdgcn_exp2f(-1.4426950408889634f * zz);
                        const float gl = cv * __builtin_amdgcn_rcpf(1.0f + ex);
                        f[e] = gl * acc[ai][bj][m][e >> 2][e & 3];
                    }
                    u32x4 w; w.x = cvt_pk_bf16(f[0], f[1]); w.y = cvt_pk_bf16(f[2], f[3]); w.z = cvt_pk_bf16(f[4], f[5]); w.w = cvt_pk_bf16(f[6], f[7]);
                    *(u32x4*)(Fo + (size_t)row * ff + col) = w;
                }
        }
    }
};
template <class Epi, class Sched, bool ALIGN_EPI = false, bool SP2 = false>
__device__ __forceinline__ void gemm_phase(PG8_LAS unsigned char* lds, const Gemm g, const Sched& S, const Epi& E) {
    int tid_l = threadIdx.x; asm volatile("" : "+v"(tid_l));
    const int tid = tid_l, wid = __builtin_amdgcn_readfirstlane(tid >> 6), lane = tid & 63, wr = wid >> 2, wc = wid & 3, fr = lane & 15, fq = lane >> 4;
    const int K = g.K, nt = K / BK;
    unsigned voffA[2], voffB[2];
#pragma unroll
    for (int i = 0; i < 2; ++i) { int R, C; stage_rc(tid * 16 + i * 8192, R, C); const int Rb = Epi::PERM ? ((R & ~31) + perm32(R & 31)) : R;
        voffA[i] = (unsigned)(R * K + C) * 2u; voffB[i] = (unsigned)(Rb * K + C) * 2u; }
    const size_t kstep = (size_t)(BK * 2);
    const size_t hstep = (size_t)HALF * K * 2;
    const size_t tstep = 2 * hstep;
    const unsigned ldsw = (unsigned)wid * 1024u;
    const int aoff = lds_byte(wr * 64 + fr, fq * 8), boff = lds_byte(wc * 32 + fr, fq * 8);
#define PG8_SA(b, h) (((b) * 2 + (h)) * HTB)
#define PG8_SB(b, h) ((4 + (b) * 2 + (h)) * HTB)
#define PG8_STAGE(bufoff, gbase, voff) do { _Pragma("unroll") for (int _i = 0; _i < 2; ++_i) \
        __builtin_amdgcn_global_load_lds((const unsigned*)((const char*)(gbase) + (voff)[_i]), (PG8_LAS unsigned*)(lds + (bufoff) + ldsw + _i * 8192), 16, 0, 0); } while (0)
#define PG8_LDA(dst, b, h) do { _Pragma("unroll") for (int m = 0; m < 4; ++m) _Pragma("unroll") for (int k = 0; k < 2; ++k) dst[m][k] = *(const PG8_LAS bf16x8*)(lds + PG8_SA(b, h) + aoff + m * 2048 + k * 1024); } while (0)
#define PG8_LDB(dst, b, h) do { _Pragma("unroll") for (int n = 0; n < 2; ++n) _Pragma("unroll") for (int k = 0; k < 2; ++k) dst[n][k] = *(const PG8_LAS bf16x8*)(lds + PG8_SB(b, h) + boff + n * 2048 + k * 1024); } while (0)
#define PG8_MMA(ai, bj, At, Bt) do { __builtin_amdgcn_s_setprio(1); _Pragma("unroll") for (int m = 0; m < 4; ++m) _Pragma("unroll") for (int n = 0; n < 2; ++n) _Pragma("unroll") for (int k = 0; k < 2; ++k) \
        acc[ai][bj][m][n] = __builtin_amdgcn_mfma_f32_16x16x32_bf16(Bt[n][k], At[m][k], acc[ai][bj][m][n], 0, 0, 0); __builtin_amdgcn_s_setprio(0); } while (0)
#define PG8_WAIT_V(n) asm volatile("s_waitcnt vmcnt(" #n ")" ::: "memory")
#define PG8_WAIT_L(n) asm volatile("s_waitcnt lgkmcnt(" #n ")" ::: "memory")
#define PG8_BAR __builtin_amdgcn_s_barrier()
#define PG8_SCHED __builtin_amdgcn_sched_barrier(0)
    Unit cur, nxt; int ui = 0;
    if (!S.next(0, cur)) return;
    f32x4 acc[2][2][4][2];
#pragma unroll
    for (int a = 0; a < 2; ++a)
#pragma unroll
        for (int b = 0; b < 2; ++b)
#pragma unroll
            for (int m = 0; m < 4; ++m)
#pragma unroll
                for (int n = 0; n < 2; ++n) acc[a][b][m][n] = (f32x4){0.f, 0.f, 0.f, 0.f};
    bf16x8 At[4][2], B0[2][2], B1[2][2];
    const char* cA = (const char*)g.A + (size_t)cur.pm * tstep; const char* cB = (const char*)g.Bt + (size_t)cur.pn * tstep;
    S.a_ready(cur);
    if constexpr (SP2) {
        PG8_STAGE(PG8_SB(0, 0), cB, voffB); PG8_STAGE(PG8_SB(0, 1), cB + hstep, voffB); PG8_STAGE(PG8_SA(0, 0), cA, voffA); PG8_STAGE(PG8_SA(0, 1), cA + hstep, voffA);
        if (wr == 1) PG8_BAR;
        PG8_WAIT_V(2); PG8_BAR;
        PG8_STAGE(PG8_SB(1, 0), cB + kstep, voffB); PG8_STAGE(PG8_SA(1, 0), cA + kstep, voffA); PG8_STAGE(PG8_SB(1, 1), cB + hstep + kstep, voffB);
        PG8_WAIT_V(6); PG8_BAR;
    } else {
        PG8_STAGE(PG8_SB(0, 0), cB, voffB); PG8_STAGE(PG8_SA(0, 0), cA, voffA); PG8_STAGE(PG8_SB(0, 1), cB + hstep, voffB); PG8_STAGE(PG8_SA(0, 1), cA + hstep, voffA);
        if (wr == 1) PG8_BAR;
        PG8_WAIT_V(4); PG8_BAR;
        PG8_STAGE(PG8_SB(1, 0), cB + kstep, voffB); PG8_STAGE(PG8_SA(1, 0), cA + kstep, voffA); PG8_STAGE(PG8_SB(1, 1), cB + hstep + kstep, voffB);
        PG8_WAIT_V(6); PG8_BAR;
    }
    for (;;) {
        const bool has_next = S.next(ui + 1, nxt);
        const char* nA = has_next ? (const char*)g.A + (size_t)nxt.pm * tstep : cA; const char* nB = has_next ? (const char*)g.Bt + (size_t)nxt.pn * tstep : cB;
        for (int t = 0; t < nt; t += 2) {
            const bool last = (t == nt - 2);
            const char* a1 = cA + (size_t)(t + 1) * kstep;
            const char* a2 = last ? nA : cA + (size_t)(t + 2) * kstep; const char* b2 = last ? nB : cB + (size_t)(t + 2) * kstep;
            const char* a3 = a2 + kstep; const char* b3 = b2 + kstep;
            if (last && has_next) S.a_ready(nxt);
            if constexpr (SP2) {
            PG8_LDB(B0, 0, 0); PG8_LDB(B1, 0, 1); PG8_SCHED; PG8_LDA(At, 0, 0); PG8_STAGE(PG8_SA(1, 1), a1 + hstep, voffA);
            PG8_WAIT_V(8); PG8_WAIT_L(0); PG8_BAR; PG8_MMA(0, 0, At, B0); PG8_MMA(0, 1, At, B1); PG8_BAR; PG8_SCHED;
            PG8_LDA(At, 0, 1); PG8_STAGE(PG8_SB(0, 0), b2, voffB); PG8_STAGE(PG8_SB(0, 1), b2 + hstep, voffB); PG8_STAGE(PG8_SA(0, 0), a2, voffA);
            PG8_WAIT_V(8); PG8_WAIT_L(0); PG8_BAR; PG8_MMA(1, 0, At, B0); PG8_MMA(1, 1, At, B1); PG8_BAR; PG8_SCHED;
            PG8_LDB(B0, 1, 0); PG8_LDB(B1, 1, 1); PG8_SCHED; PG8_LDA(At, 1, 0); PG8_STAGE(PG8_SA(0, 1), a2 + hstep, voffA);
            PG8_WAIT_V(8); PG8_WAIT_L(0); PG8_BAR; PG8_MMA(0, 0, At, B0); PG8_MMA(0, 1, At, B1); PG8_BAR; PG8_SCHED;
            PG8_LDA(At, 1, 1); PG8_STAGE(PG8_SB(1, 0), b3, voffB); PG8_STAGE(PG8_SB(1, 1), b3 + hstep, voffB); PG8_STAGE(PG8_SA(1, 0), a3, voffA);
            PG8_WAIT_V(8); PG8_WAIT_L(0); PG8_BAR; PG8_MMA(1, 0, At, B0); PG8_MMA(1, 1, At, B1); PG8_BAR; PG8_SCHED;
            } else {
            PG8_LDB(B0, 0, 0); PG8_SCHED; PG8_LDA(At, 0, 0); PG8_STAGE(PG8_SA(1, 1), a1 + hstep, voffA);
            PG8_WAIT_L(8); PG8_BAR; PG8_WAIT_L(0); PG8_MMA(0, 0, At, B0); PG8_BAR; PG8_SCHED;
            PG8_LDB(B1, 0, 1); PG8_STAGE(PG8_SB(0, 0), b2, voffB);
            PG8_BAR; PG8_WAIT_L(0); PG8_MMA(0, 1, At, B1); PG8_BAR;
            PG8_LDA(At, 0, 1); PG8_STAGE(PG8_SA(0, 0), a2, voffA);
            PG8_BAR; PG8_WAIT_L(0); PG8_MMA(1, 0, At, B0); PG8_BAR; PG8_SCHED;
            PG8_STAGE(PG8_SB(0, 1), b2 + hstep, voffB);
            PG8_WAIT_V(6); PG8_BAR; PG8_MMA(1, 1, At, B1); PG8_BAR;
            PG8_LDB(B0, 1, 0); PG8_SCHED; PG8_LDA(At, 1, 0); PG8_STAGE(PG8_SA(0, 1), a2 + hstep, voffA);
            PG8_WAIT_L(8); PG8_BAR; PG8_WAIT_L(0); PG8_MMA(0, 0, At, B0); PG8_BAR; PG8_SCHED;
            PG8_LDB(B1, 1, 1); PG8_STAGE(PG8_SB(1, 0), b3, voffB);
            PG8_BAR; PG8_WAIT_L(0); PG8_MMA(0, 1, At, B1); PG8_BAR;
            PG8_LDA(At, 1, 1); PG8_STAGE(PG8_SA(1, 0), a3, voffA);
            PG8_BAR; PG8_WAIT_L(0); PG8_MMA(1, 0, At, B0); PG8_BAR; PG8_SCHED;
            PG8_STAGE(PG8_SB(1, 1), b3 + hstep, voffB);
            PG8_WAIT_V(6); PG8_BAR; PG8_MMA(1, 1, At, B1); PG8_BAR;
            }
        }
        if constexpr (ALIGN_EPI) { if (wr == 0) PG8_BAR; }
        if constexpr (!Epi::AFTER_DRAIN) { E(acc, cur, wr, wc, fr, fq); S.done(cur); }
        if (!has_next) break;
#pragma unroll
        for (int a = 0; a < 2; ++a)
#pragma unroll
            for (int b = 0; b < 2; ++b)
#pragma unroll
                for (int m = 0; m < 4; ++m)
#pragma unroll
                    for (int n = 0; n < 2; ++n) acc[a][b][m][n] = (f32x4){0.f, 0.f, 0.f, 0.f};
        cur = nxt; cA = nA; cB = nB; ++ui;
        if constexpr (ALIGN_EPI) { if (wr == 1) PG8_BAR; }
    }
    PG8_WAIT_V(0);
    if constexpr (!ALIGN_EPI) { if (wr == 0) PG8_BAR; }
    PG8_BAR;
    if constexpr (Epi::AFTER_DRAIN) { E.fused(acc, cur, wr, wc, fr, fq, lds, wid, lane); S.done(cur); }
#undef PG8_SA
#undef PG8_SB
#undef PG8_STAGE
#undef PG8_LDA
#undef PG8_LDB
#undef PG8_MMA
#undef PG8_WAIT_V
#undef PG8_WAIT_L
#undef PG8_BAR
#undef PG8_SCHED
}
}
#define LAS __attribute__((address_space(3)))
typedef unsigned short bf16_t;
typedef short bf16x8 __attribute__((ext_vector_type(8)));
typedef short s16x4 __attribute__((ext_vector_type(4)));
typedef float f32x4 __attribute__((ext_vector_type(4)));
typedef float f32x16 __attribute__((ext_vector_type(16)));
typedef unsigned u32x4 __attribute__((ext_vector_type(4)));
typedef unsigned u32x2 __attribute__((ext_vector_type(2)));
using pg8::cvt_pk_bf16;

constexpr int NB = 8, S = 4096, D = 1024, M = NB * S, FF = 2816, NQKV = 4608;
constexpr float LAM_INIT = 0.35550906759096934f;
constexpr size_t MiB = 1u << 20;
constexpr size_t WS_MODS = 0, WS_ROPE = 1 * MiB, WS_SSQ = 3 * MiB, WS_LSE = 5 * MiB;
constexpr size_t WS_WQKV = 8 * MiB, WS_WOA = 17 * MiB, WS_WG0 = 18 * MiB, WS_WU0 = WS_WG0 + 5767168, WS_WD0 = WS_WU0 + 5767168, WS_WG1 = WS_WD0 + 5767168, WS_WU1 = WS_WG1 + 5767168, WS_WD1 = WS_WU1 + 5767168;
constexpr size_t WS_WKV = 53 * MiB, WS_WQ1 = 57 * MiB, WS_WOB = 59 * MiB;
static_assert(WS_WD1 + 5767168 <= WS_WKV && WS_WOB + 2 * MiB <= 64 * MiB, "weights map");
constexpr size_t WS_H = 64 * MiB, WS_R = 128 * MiB, WS_END = 512 * MiB;
constexpr int LDS_BYTES = 147456;

__device__ __forceinline__ float wave_sum(float v) {
#pragma unroll
    for (int o = 1; o < 64; o <<= 1) v += __shfl_xor(v, o);
    return v;
}
__device__ __forceinline__ float bflo(unsigned w) { return __uint_as_float(w << 16); }
__device__ __forceinline__ float bfhi(unsigned w) { return __uint_as_float(w & 0xffff0000u); }

template <int DV, bool WINDOW>
__device__ __forceinline__ void attn_core(LAS unsigned char* lds, const bf16_t* Qp, size_t ldq, const bf16_t* Kp, size_t ldk, const bf16_t* Vp, size_t ldv, int i0,
                                          f32x16 (&o)[DV / 32], float& m_run, float& l_run) {
    constexpr int KROW = 144, VROW = DV * 2 + 64, KBYTES = 64 * KROW, VBYTES = 64 * VROW, STAGE = KBYTES + VBYTES, NV = DV / 64, NO = DV / 32;
    int tid_l = threadIdx.x; asm volatile("" : "+v"(tid_l));
    const int tid = tid_l, lane = tid & 63, wid = __builtin_amdgcn_readfirstlane(tid >> 6), r32 = lane & 31, hi = lane >> 5;
    const bf16_t* qrow = Qp + (size_t)(wid * 32 + r32) * ldq + hi * 8;
    bf16x8 qf[4];
#pragma unroll
    for (int d0 = 0; d0 < 4; ++d0) qf[d0] = *(const bf16x8*)(qrow + d0 * 16);
    const int qmin = i0 + wid * 32, qi = qmin + r32;
    const int t_lo = WINDOW ? (((i0 >> 6) - 2) > 0 ? ((i0 >> 6) - 2) : 0) : 0, t_hi = (i0 >> 6) + 4;
    const int wt_lo = WINDOW ? ((((qmin - 128) >> 6) > 0) ? ((qmin - 128) >> 6) : 0) : 0, wt_hi = ((qmin + 31) >> 6) + 1;
    const int skey = tid >> 3, sch = tid & 7;
    const bf16_t* kg = Kp + (size_t)skey * ldk + sch * 8;
    const bf16_t* vg = Vp + (size_t)skey * ldv + sch * 8;
    LAS unsigned char* ks = lds + skey * KROW + sch * 16;
    LAS unsigned char* vs = lds + KBYTES + skey * VROW + sch * 16;
    const LAS unsigned char* kr = lds + r32 * KROW + hi * 16;
    const LAS unsigned char* vr = lds + KBYTES + (4 * hi + ((lane & 15) >> 2)) * VROW + (((lane >> 4) & 1) * 16 + (lane & 3) * 4) * 2;
#pragma unroll
    for (int i = 0; i < NO; ++i)
#pragma unroll
        for (int r = 0; r < 16; ++r) o[i][r] = 0.f;
    float mr = -1e30f, lr = 0.f;
    u32x4 kreg, vreg[NV];
#define ATT_GLOAD(t) do { kreg = *(const u32x4*)(kg + (size_t)(t) * 64 * ldk); _Pragma("unroll") for (int i_ = 0; i_ < NV; ++i_) vreg[i_] = *(const u32x4*)(vg + (size_t)(t) * 64 * ldv + i_ * 64); } while (0)
#define ATT_LSTORE(st) do { *(LAS u32x4*)(ks + (st) * STAGE) = kreg; _Pragma("unroll") for (int i_ = 0; i_ < NV; ++i_) *(LAS u32x4*)(vs + (st) * STAGE + i_ * 128) = vreg[i_]; } while (0)
    ATT_GLOAD(t_lo); ATT_LSTORE(0);
    __syncthreads();
    int st = 0;
    for (int t = t_lo; t < t_hi; ++t) {
        const bool more = (t + 1 < t_hi);
        if (more) ATT_GLOAD(t + 1);
        if (t >= wt_lo && t < wt_hi) {
            const LAS unsigned char* kb = kr + st * STAGE;
            const LAS unsigned char* vb = vr + st * STAGE;
            f32x16 p0, p1;
#pragma unroll
            for (int r = 0; r < 16; ++r) { p0[r] = 0.f; p1[r] = 0.f; }
#pragma unroll
            for (int d0 = 0; d0 < 4; ++d0) {
                const bf16x8 k0 = *(const LAS bf16x8*)(kb + d0 * 32);
                const bf16x8 k1 = *(const LAS bf16x8*)(kb + 32 * KROW + d0 * 32);
                p0 = __builtin_amdgcn_mfma_f32_32x32x16_bf16(k0, qf[d0], p0, 0, 0, 0);
                p1 = __builtin_amdgcn_mfma_f32_32x32x16_bf16(k1, qf[d0], p1, 0, 0, 0);
            }
            const int tk = t * 64;
            const bool needmask = WINDOW ? !((tk + 63 <= qmin) && (tk >= qmin + 31 - 128)) : (tk + 63 > qmin);
            if (needmask) {
#pragma unroll
                for (int r = 0; r < 16; ++r) {
                    const int kk = tk + 4 * hi + (r & 3) + 8 * (r >> 2);
                    const bool ok0 = (kk <= qi) && (!WINDOW || kk >= qi - 128);
                    const bool ok1 = (kk + 32 <= qi) && (!WINDOW || kk + 32 >= qi - 128);
                    p0[r] = ok0 ? p0[r] : -1e30f; p1[r] = ok1 ? p1[r] : -1e30f;
                }
            }
            float mx = fmaxf(p0[0], p1[0]);
#pragma unroll
            for (int r = 1; r < 16; ++r) mx = fmaxf(mx, fmaxf(p0[r], p1[r]));
            mx = fmaxf(mx, __shfl_xor(mx, 32));
            const float mnew = fmaxf(mr, mx);
            const float alpha = __builtin_amdgcn_exp2f(mr - mnew);
            mr = mnew;
            float ls = 0.f;
#pragma unroll
            for (int r = 0; r < 16; ++r) { p0[r] = __builtin_amdgcn_exp2f(p0[r] - mnew); p1[r] = __builtin_amdgcn_exp2f(p1[r] - mnew); ls += p0[r] + p1[r]; }
            lr = lr * alpha + ls;
#pragma unroll
            for (int i = 0; i < NO; ++i)
#pragma unroll
                for (int r = 0; r < 16; ++r) o[i][r] *= alpha;
            bf16x8 pf[4];
            { u32x4 w;
              w.x = cvt_pk_bf16(p0[0], p0[1]); w.y = cvt_pk_bf16(p0[2], p0[3]); w.z = cvt_pk_bf16(p0[4], p0[5]); w.w = cvt_pk_bf16(p0[6], p0[7]); pf[0] = __builtin_bit_cast(bf16x8, w);
              w.x = cvt_pk_bf16(p0[8], p0[9]); w.y = cvt_pk_bf16(p0[10], p0[11]); w.z = cvt_pk_bf16(p0[12], p0[13]); w.w = cvt_pk_bf16(p0[14], p0[15]); pf[1] = __builtin_bit_cast(bf16x8, w);
              w.x = cvt_pk_bf16(p1[0], p1[1]); w.y = cvt_pk_bf16(p1[2], p1[3]); w.z = cvt_pk_bf16(p1[4], p1[5]); w.w = cvt_pk_bf16(p1[6], p1[7]); pf[2] = __builtin_bit_cast(bf16x8, w);
              w.x = cvt_pk_bf16(p1[8], p1[9]); w.y = cvt_pk_bf16(p1[10], p1[11]); w.z = cvt_pk_bf16(p1[12], p1[13]); w.w = cvt_pk_bf16(p1[14], p1[15]); pf[3] = __builtin_bit_cast(bf16x8, w); }
#pragma unroll
            for (int s = 0; s < 4; ++s)
#pragma unroll
                for (int i = 0; i < NO; ++i) {
                    const LAS unsigned char* ap = vb + (16 * s) * VROW + i * 64;
                    const s16x4 lo = __builtin_bit_cast(s16x4, __builtin_amdgcn_ds_read_tr16_b64_v4i16((LAS s16x4*)ap));
                    const s16x4 h4 = __builtin_bit_cast(s16x4, __builtin_amdgcn_ds_read_tr16_b64_v4i16((LAS s16x4*)(ap + 8 * VROW)));
                    const bf16x8 vf = (bf16x8){lo[0], lo[1], lo[2], lo[3], h4[0], h4[1], h4[2], h4[3]};
                    o[i] = __builtin_amdgcn_mfma_f32_32x32x16_bf16(vf, pf[s], o[i], 0, 0, 0);
                }
        }
        if (more) ATT_LSTORE(st ^ 1);
        __syncthreads();
        st ^= 1;
    }
#undef ATT_GLOAD
#undef ATT_LSTORE
    m_run = mr; l_run = lr + __shfl_xor(lr, 32);
}

#ifndef ONLY
#define PH(k) true
#else
#define PH(k) ((ONLY) == (k))
#endif
struct Args { const void* in[30]; float* out; unsigned char* ws; };

__device__ __forceinline__ int permcol(int n, int pmode) {
    const bool rot = (pmode == 1) || (pmode == 2 && (n % 1536) < 1024);
    const int nn = n & 63;
    if (rot && nn < 16) return (n & ~63) + 2 * (nn & 7) + (nn >> 3);
    return n;
}
__device__ __forceinline__ void transpose_item(const float* W, int K, int N, bf16_t* WT, int row_off, int pmode, LAS float* scr, int item, int lane) {
    const int nblk = N / 32, kb = item / nblk, nb = item % nblk, k0 = 64 * kb, n0 = 32 * nb;
#pragma unroll 8
    for (int i = 0; i < 32; ++i) { const int kk = 2 * i + (lane >> 5); scr[kk * 33 + (lane & 31)] = W[(size_t)(k0 + kk) * N + n0 + (lane & 31)]; }
    asm volatile("s_waitcnt lgkmcnt(0)" ::: "memory");
    const int c = lane & 7;
#pragma unroll
    for (int j = 0; j < 4; ++j) { const int n = (lane >> 3) + 8 * j; const LAS float* s = scr + (8 * c) * 33 + n;
        u32x4 o; o.x = cvt_pk_bf16(s[0 * 33], s[1 * 33]); o.y = cvt_pk_bf16(s[2 * 33], s[3 * 33]); o.z = cvt_pk_bf16(s[4 * 33], s[5 * 33]); o.w = cvt_pk_bf16(s[6 * 33], s[7 * 33]);
        *(u32x4*)(WT + (size_t)(row_off + permcol(n0 + n, pmode)) * K + k0 + 8 * c) = o; }
    asm volatile("s_waitcnt lgkmcnt(0)" ::: "memory");
}

__device__ __forceinline__ f32x4 ld4(const float* p) { return *(const f32x4*)p; }

template <bool HAS_Y, int NH>
__device__ __forceinline__ void thin_pass(int gw, int NGW, int lane, const float* xin, float* xout, const float* Y, const float* ssqp,
                                          const float* gpost, const float* gate,
                                          const float* g1, const float* sc1, const float* sh1, bf16_t* H1,
                                          const float* g2, const float* sc2, const float* sh2, bf16_t* H2) {
    asm volatile("" : "+v"(lane));
    const int rpw = (M + NGW - 1) / NGW; const int r0 = gw * rpw; const int r1 = (r0 + rpw < M) ? (r0 + rpw) : M;
    int curb = -1; f32x4 GG[4], A1[4], B1[4], A2[4], B2[4];
    for (int row = r0; row < r1; ++row) {
        const int b = row >> 12;
        if (b != curb) { curb = b;
#pragma unroll
            for (int j = 0; j < 4; ++j) { const int c = 4 * lane + 256 * j;
                if (HAS_Y) GG[j] = ld4(gpost + c) * ld4(gate + b * 3072 + c);
                if (NH >= 1) { A1[j] = ld4(g1 + c) * (ld4(sc1 + b * 3072 + c) + 1.0f); B1[j] = ld4(sh1 + b * 3072 + c); }
                if (NH >= 2) { A2[j] = ld4(g2 + c) * (ld4(sc2 + b * 3072 + c) + 1.0f); B2[j] = ld4(sh2 + b * 3072 + c); } } }
        f32x4 x[4];
#pragma unroll
        for (int j = 0; j < 4; ++j) x[j] = ld4(xin + (size_t)row * D + 4 * lane + 256 * j);
        if (HAS_Y) {
            f32x4 y[4];
#pragma unroll
            for (int j = 0; j < 4; ++j) y[j] = ld4(Y + (size_t)row * D + 4 * lane + 256 * j);
            const float pv = (lane < 16) ? ssqp[(size_t)row * 16 + lane] : 0.f;
            const float rs = 1.0f / sqrtf(wave_sum(pv) * (1.0f / D) + 1e-6f);
#pragma unroll
            for (int j = 0; j < 4; ++j) { x[j] = x[j] + GG[j] * (y[j] * rs); *(f32x4*)(xout + (size_t)row * D + 4 * lane + 256 * j) = x[j]; }
        }
        if (NH >= 1) {
            float s = 0.f;
#pragma unroll
            for (int j = 0; j < 4; ++j) s += (x[j][0] * x[j][0] + x[j][1] * x[j][1]) + (x[j][2] * x[j][2] + x[j][3] * x[j][3]);
            const float rstd = 1.0f / sqrtf(wave_sum(s) * (1.0f / D) + 1e-6f);
#pragma unroll
            for (int j = 0; j < 4; ++j) { const f32x4 h = (x[j] * rstd) * A1[j] + B1[j]; u32x2 w; w.x = cvt_pk_bf16(h[0], h[1]); w.y = cvt_pk_bf16(h[2], h[3]);
                *(u32x2*)(H1 + (size_t)row * D + 4 * lane + 256 * j) = w; }
            if (NH >= 2) {
#pragma unroll
                for (int j = 0; j < 4; ++j) { const f32x4 h = (x[j] * rstd) * A2[j] + B2[j]; u32x2 w; w.x = cvt_pk_bf16(h[0], h[1]); w.y = cvt_pk_bf16(h[2], h[3]);
                    *(u32x2*)(H2 + (size_t)row * D + 4 * lane + 256 * j) = w; }
            }
        }
    }
}

__global__ void __launch_bounds__(512, 2) mk_fwd(Args a) {
    extern __shared__ __attribute__((aligned(16))) unsigned char lds_raw[];
    LAS unsigned char* lds = (LAS unsigned char*)lds_raw;
    cg::grid_group grid = cg::this_grid();
    const int tid = threadIdx.x, lane = tid & 63, wave = __builtin_amdgcn_readfirstlane(tid >> 6);
    const int G = gridDim.x, bx = blockIdx.x;
    const int vcu = (G % 8 == 0) ? (bx % 8) * (G / 8) + bx / 8 : bx;
    const int gw = vcu * 8 + wave, NGW = G * 8;
    unsigned char* ws = a.ws;
    const float* x_in = (const float*)a.in[0];
    const float* c_in = (const float*)a.in[1];
    const int* pos_in = (const int*)a.in[2];
    const float* mod_mix_w = (const float*)a.in[3]; const float* mod_mix_b = (const float*)a.in[4];
    const float* mod_ffn_w = (const float*)a.in[5]; const float* mod_ffn_b = (const float*)a.in[6];
    const float* norm_pre_mix = (const float*)a.in[7]; const float* norm_post_mix = (const float*)a.in[8];
    const float* norm_pre_ffn = (const float*)a.in[9]; const float* norm_post_ffn = (const float*)a.in[10];
    const float* ffn_w_gate = (const float*)a.in[11]; const float* ffn_w_up = (const float*)a.in[12];
    const float* ffn_conv_w = (const float*)a.in[13]; const float* ffn_conv_b = (const float*)a.in[14];
    const float* ffn_w_down = (const float*)a.in[15];
    const float* a_w_qkv = (const float*)a.in[16]; const float* a_w_o = (const float*)a.in[17];
    const float* kv_norm = (const float*)a.in[18]; const float* kv_mod_w = (const float*)a.in[19]; const float* kv_mod_b = (const float*)a.in[20];
    const float* b_w_k = (const float*)a.in[21]; const float* b_w_v = (const float*)a.in[22]; const float* b_w_q = (const float*)a.in[23];
    const float* lq1 = (const float*)a.in[24]; const float* lk1 = (const float*)a.in[25]; const float* lq2 = (const float*)a.in[26]; const float* lk2 = (const float*)a.in[27];
    const float* b_subln = (const float*)a.in[28]; const float* b_w_o = (const float*)a.in[29];
    float* out = a.out;
    float* MODS = (float*)(ws + WS_MODS);
    float* ROPE = (float*)(ws + WS_ROPE);
    float* SSQ = (float*)(ws + WS_SSQ);
    float* LSE = (float*)(ws + WS_LSE);
    bf16_t* WQKV = (bf16_t*)(ws + WS_WQKV); bf16_t* WOA = (bf16_t*)(ws + WS_WOA);
    bf16_t* WKV = (bf16_t*)(ws + WS_WKV); bf16_t* WQ1 = (bf16_t*)(ws + WS_WQ1); bf16_t* WOB = (bf16_t*)(ws + WS_WOB);
    bf16_t* Hb = (bf16_t*)(ws + WS_H);
    unsigned char* R = ws + WS_R;

    if (PH(0) && bx < 224) {
        const float* W; const float* bias; int ldw, col0; float* mo;
        if (bx < 192) { const int mat = bx / 48, cb = bx % 48; const int l = mat >> 1; col0 = cb * 64; ldw = 3072;
            W = ((mat & 1) ? mod_ffn_w : mod_mix_w) + (size_t)l * D * 3072; bias = ((mat & 1) ? mod_ffn_b : mod_mix_b) + l * 3072; mo = MODS + (size_t)mat * 8 * 3072; }
        else { const int cb = bx - 192; col0 = cb * 64; ldw = 2048; W = kv_mod_w; bias = kv_mod_b; mo = MODS + (size_t)4 * 8 * 3072; }
        LAS float* cact = (LAS float*)lds;
        LAS float* red = (LAS float*)(lds + 32768);
        for (int i = tid; i < 8 * 1024; i += 512) { const int b = i >> 10, k = i & 1023; const float cv = c_in[b * 1024 + k]; cact[k * 8 + b] = cv / (1.0f + __expf(-cv)); }
        __syncthreads();
        float acc[8];
#pragma unroll
        for (int b = 0; b < 8; ++b) acc[b] = 0.f;
        const float* wp = W + (size_t)(wave * 128) * ldw + col0 + lane;
#pragma unroll 8
        for (int k = 0; k < 128; ++k) {
            const float w = wp[(size_t)k * ldw];
            const f32x4 c0 = *(const LAS f32x4*)(cact + (wave * 128 + k) * 8), c1 = *(const LAS f32x4*)(cact + (wave * 128 + k) * 8 + 4);
            acc[0] += c0[0] * w; acc[1] += c0[1] * w; acc[2] += c0[2] * w; acc[3] += c0[3] * w;
            acc[4] += c1[0] * w; acc[5] += c1[1] * w; acc[6] += c1[2] * w; acc[7] += c1[3] * w;
        }
#pragma unroll
        for (int b = 0; b < 8; ++b) red[(wave * 8 + b) * 64 + lane] = acc[b];
        __syncthreads();
        { const int b = tid >> 6; float s = bias[col0 + lane];
#pragma unroll
          for (int w = 0; w < 8; ++w) s += red[(w * 8 + b) * 64 + lane];
          mo[b * 3072 + col0 + lane] = s; }
        __syncthreads();
    }
    if (PH(0)) {
        const float invf[8] = {1.0f, 0.1939227432012558f, 0.03760603070259094f, 0.007292664609849453f, 0.0014142135623842478f, 0.00027424818836152554f, 5.318296098266728e-05f, 1.0313386155758053e-05f};
        for (int i = bx * 512 + tid; i < M * 8; i += G * 512) {
            const int row = i >> 3, j = i & 7;
            float iv = invf[0];
#pragma unroll
            for (int q = 1; q < 8; ++q) iv = (j == q) ? invf[q] : iv;
            const float ang = (float)pos_in[row] * iv;
            double rev = (double)ang * 0.15915494309189535; rev -= __builtin_rint(rev);
            const float rf = (float)rev;
            ROPE[(size_t)i * 2] = __builtin_amdgcn_cosf(rf); ROPE[(size_t)i * 2 + 1] = __builtin_amdgcn_sinf(rf);
        }
    }
    if (PH(0)) {
        LAS float* scr = (LAS float*)(lds + wave * 16384);
        constexpr int I_QKV = 16 * 144, I_OA = 8 * 32, I_GU = 16 * 88, I_DN = 44 * 32, I_SQ = 16 * 32;
        constexpr int NITEMS = I_QKV + I_OA + 4 * I_GU + 2 * I_DN + 4 * I_SQ;
        for (int it = gw; it < NITEMS; it += NGW) {
            int r = it;
            if (r < I_QKV) { transpose_item(a_w_qkv, D, NQKV, WQKV, 0, 2, scr, r, lane); continue; } r -= I_QKV;
            if (r < I_OA) { transpose_item(a_w_o, 512, D, WOA, 0, 0, scr, r, lane); continue; } r -= I_OA;
            if (r < 4 * I_GU) { const int w = r / I_GU, l = w >> 1, up = w & 1; r -= w * I_GU;
                transpose_item((up ? ffn_w_up : ffn_w_gate) + (size_t)l * D * FF, D, FF, (bf16_t*)(ws + (l ? (up ? WS_WU1 : WS_WG1) : (up ? WS_WU0 : WS_WG0))), 0, 0, scr, r, lane); continue; } r -= 4 * I_GU;
            if (r < 2 * I_DN) { const int l = r / I_DN; r -= l * I_DN;
                transpose_item(ffn_w_down + (size_t)l * FF * D, FF, D, (bf16_t*)(ws + (l ? WS_WD1 : WS_WD0)), 0, 0, scr, r, lane); continue; } r -= 2 * I_DN;
            if (r < I_SQ) { transpose_item(b_w_k, D, D, WKV, 0, 1, scr, r, lane); continue; } r -= I_SQ;
            if (r < I_SQ) { transpose_item(b_w_v, D, D, WKV, 1024, 0, scr, r, lane); continue; } r -= I_SQ;
            if (r < I_SQ) { transpose_item(b_w_q, D, D, WQ1, 0, 1, scr, r, lane); continue; } r -= I_SQ;
            transpose_item(b_w_o, D, D, WOB, 0, 0, scr, r, lane);
        }
    }
    grid.sync();

    if (PH(1)) thin_pass<false, 1>(gw, NGW, lane, x_in, nullptr, nullptr, nullptr, nullptr, nullptr,
                        norm_pre_mix, MODS + 0 * 8 * 3072 + 1024, MODS + 0 * 8 * 3072, Hb, nullptr, nullptr, nullptr, nullptr);
    grid.sync();

    bf16_t* QKV0 = (bf16_t*)R;
    if (PH(2)) {
        pg8::Gemm g{Hb, WQKV, M, NQKV, D}; pg8::StaticOrder So; So.init(M, NQKV, G, bx);
        pg8::EpiRope<0> E{QKV0, NQKV, ROPE, 0};
        pg8::gemm_phase<pg8::EpiRope<0>, pg8::StaticOrder, true, true>(lds, g, So, E);
    }
    grid.sync();

    bf16_t* OG = (bf16_t*)(R + 288 * MiB);
    if (PH(3)) for (int u = vcu; u < 3072; u += G) {
        const int bgh = u >> 4, qblk = u & 15; const int b = bgh / 24, g = (bgh % 24) >> 3, h = bgh & 7;
        const int dil = (g == 0) ? 1 : (g == 1 ? 4 : 16), L = S / dil;
        const int p0 = qblk * 256, rs = p0 / L, i0 = p0 % L;
        const size_t segbase = (size_t)b * S + (size_t)rs * L;
        const bf16_t* Qp = QKV0 + ((size_t)b * S + p0) * NQKV + g * 1536 + h * 64;
        const bf16_t* Kp = QKV0 + segbase * NQKV + g * 1536 + 512 + h * 64;
        const bf16_t* Vp = QKV0 + segbase * NQKV + g * 1536 + 1024 + h * 64;
        f32x16 o[2]; float mr, lr;
        attn_core<64, true>(lds, Qp, NQKV, Kp, NQKV, Vp, NQKV, i0, o, mr, lr);
        const int r32 = lane & 31, hi = lane >> 5;
        const int qi = i0 + wave * 32 + r32;
        const size_t row = (size_t)b * S + (size_t)qi * dil + rs;
        const float inv = 1.0f / lr;
        bf16_t* op = OG + ((size_t)g * M + row) * 512 + h * 64 + 4 * hi;
#pragma unroll
        for (int i = 0; i < 2; ++i)
#pragma unroll
            for (int q4 = 0; q4 < 4; ++q4) { u32x2 w; w.x = cvt_pk_bf16(o[i][4 * q4] * inv, o[i][4 * q4 + 1] * inv); w.y = cvt_pk_bf16(o[i][4 * q4 + 2] * inv, o[i][4 * q4 + 3] * inv);
                *(u32x2*)(op + i * 32 + 8 * q4) = w; }
        if (hi == 0) LSE[((size_t)g * M + row) * 8 + h] = mr + __log2f(lr);
    }
    grid.sync();

    bf16_t* MIX = Hb;
    if (PH(4)) {
        int lane_o = lane; asm volatile("" : "+v"(lane_o)); const int lane = lane_o;
        const int rpw = (M + NGW - 1) / NGW; const int r0 = gw * rpw; const int r1 = (r0 + rpw < M) ? (r0 + rpw) : M;
        for (int row = r0; row < r1; ++row) {
            const int h = lane >> 3;
            const float l0 = LSE[((size_t)0 * M + row) * 8 + h], l1 = LSE[((size_t)1 * M + row) * 8 + h], l2 = LSE[((size_t)2 * M + row) * 8 + h];
            const float mx = fmaxf(l0, fmaxf(l1, l2));
            float w0 = __builtin_amdgcn_exp2f(l0 - mx), w1 = __builtin_amdgcn_exp2f(l1 - mx), w2 = __builtin_amdgcn_exp2f(l2 - mx);
            const float ws_ = 1.0f / (w0 + w1 + w2); w0 *= ws_; w1 *= ws_; w2 *= ws_;
            const u32x4 a0 = *(const u32x4*)(OG + ((size_t)0 * M + row) * 512 + 8 * lane), a1 = *(const u32x4*)(OG + ((size_t)1 * M + row) * 512 + 8 * lane), a2 = *(const u32x4*)(OG + ((size_t)2 * M + row) * 512 + 8 * lane);
            u32x4 w;
#pragma unroll
            for (int e = 0; e < 4; ++e) { const float lo = w0 * bflo(a0[e]) + w1 * bflo(a1[e]) + w2 * bflo(a2[e]), hh = w0 * bfhi(a0[e]) + w1 * bfhi(a1[e]) + w2 * bfhi(a2[e]); w[e] = cvt_pk_bf16(lo, hh); }
            *(u32x4*)(MIX + (size_t)row * 512 + 8 * lane) = w;
        }
    }
    grid.sync();

    float* Y = (float*)R;
    if (PH(5)) {
        pg8::Gemm g{MIX, WOA, M, D, 512}; pg8::StaticOrder So; So.init(M, D, G, bx);
        pg8::EpiY E{Y, D, SSQ};
        pg8::gemm_phase<pg8::EpiY, pg8::StaticOrder, true, true>(lds, g, So, E);
    }
    grid.sync();

    for (int l = 0; l < 2; ++l) {
        if (l == 1) {
            bf16_t* HK = (bf16_t*)(R + 128 * MiB);
            bf16_t* Kb = (bf16_t*)(R + 192 * MiB);
            bf16_t* Qb = (bf16_t*)R;
            if (PH(6)) {
                pg8::Gemm g{HK, WKV, M, 2048, D}; pg8::StaticOrder So; So.init(M, 2048, G, bx);
                pg8::EpiRope<1> E{Kb, D, ROPE, (size_t)M * D};
                pg8::gemm_phase<pg8::EpiRope<1>, pg8::StaticOrder, true, true>(lds, g, So, E);
            }
            if (PH(7)) {
                pg8::Gemm g{Hb, WQ1, M, D, D}; pg8::StaticOrder So; So.init(M, D, G, bx);
                pg8::EpiRope<2> E{Qb, D, ROPE, 0};
                pg8::gemm_phase<pg8::EpiRope<2>, pg8::StaticOrder, true, true>(lds, g, So, E);
            }
            grid.sync();
            bf16_t* Vb = Kb + (size_t)M * D;
            bf16_t* O1 = (bf16_t*)(R + 128 * MiB);
            bf16_t* O2 = (bf16_t*)(R + 64 * MiB);
            if (PH(8)) {
                const int per = (2048 + G - 1) / G;
                for (int slot = vcu * per; slot < (vcu + 1) * per && slot < 2048; ++slot) {
                    const int combo = slot >> 4, j = slot & 15; const int qb = (j & 1) ? (15 - (j >> 1)) : (j >> 1);
                    const int b = combo >> 4, hc = combo & 15, h = hc >> 1, c = hc & 1;
                    const bf16_t* Qp = Qb + ((size_t)b * S + qb * 256) * D + hc * 64;
                    const bf16_t* Kp = Kb + ((size_t)b * S) * D + hc * 64;
                    const bf16_t* Vp = Vb + ((size_t)b * S) * D + h * 128;
                    f32x16 o[4]; float mr, lr;
                    attn_core<128, false>(lds, Qp, D, Kp, D, Vp, D, qb * 256, o, mr, lr);
                    const int r32 = lane & 31, hi = lane >> 5;
                    const size_t row = (size_t)b * S + qb * 256 + wave * 32 + r32;
                    const float inv = 1.0f / lr;
                    bf16_t* op = (c ? O2 : O1) + row * D + h * 128 + 4 * hi;
#pragma unroll
                    for (int i = 0; i < 4; ++i)
#pragma unroll
                        for (int q4 = 0; q4 < 4; ++q4) { u32x2 w; w.x = cvt_pk_bf16(o[i][4 * q4] * inv, o[i][4 * q4 + 1] * inv); w.y = cvt_pk_bf16(o[i][4 * q4 + 2] * inv, o[i][4 * q4 + 3] * inv);
                            *(u32x2*)(op + i * 32 + 8 * q4) = w; }
                }
            }
            grid.sync();
            if (PH(9)) {
                int lane_o = lane; asm volatile("" : "+v"(lane_o)); const int lane = lane_o;
                const float v1 = lq1[lane] * lk1[lane], v2 = lq2[lane] * lk2[lane];
                const float lam = __expf(wave_sum(v1)) - __expf(wave_sum(v2)) + LAM_INIT;
                float sg[16];
#pragma unroll
                for (int e = 0; e < 16; ++e) sg[e] = b_subln[16 * (lane & 7) + e] * (1.0f - LAM_INIT);
                const int rpw = (M + NGW - 1) / NGW; const int r0 = gw * rpw; const int r1 = (r0 + rpw < M) ? (r0 + rpw) : M;
                for (int row = r0; row < r1; ++row) {
                    const u32x4 p0 = *(const u32x4*)(O1 + (size_t)row * D + 16 * lane), p1 = *(const u32x4*)(O1 + (size_t)row * D + 16 * lane + 8);
                    const u32x4 q0 = *(const u32x4*)(O2 + (size_t)row * D + 16 * lane), q1 = *(const u32x4*)(O2 + (size_t)row * D + 16 * lane + 8);
                    float v[16]; float s = 0.f;
#pragma unroll
                    for (int e = 0; e < 4; ++e) { v[2 * e] = bflo(p0[e]) - lam * bflo(q0[e]); v[2 * e + 1] = bfhi(p0[e]) - lam * bfhi(q0[e]);
                        v[8 + 2 * e] = bflo(p1[e]) - lam * bflo(q1[e]); v[8 + 2 * e + 1] = bfhi(p1[e]) - lam * bfhi(q1[e]); }
#pragma unroll
                    for (int e = 0; e < 16; ++e) s += v[e] * v[e];
                    s += __shfl_xor(s, 1); s += __shfl_xor(s, 2); s += __shfl_xor(s, 4);
                    const float rstd = 1.0f / sqrtf(s * (1.0f / 128.0f) + 1e-5f);
                    u32x4 w0, w1;
#pragma unroll
                    for (int e = 0; e < 4; ++e) { w0[e] = cvt_pk_bf16(v[2 * e] * rstd * sg[2 * e], v[2 * e + 1] * rstd * sg[2 * e + 1]); w1[e] = cvt_pk_bf16(v[8 + 2 * e] * rstd * sg[8 + 2 * e], v[8 + 2 * e + 1] * rstd * sg[8 + 2 * e + 1]); }
                    *(u32x4*)(Hb + (size_t)row * D + 16 * lane) = w0; *(u32x4*)(Hb + (size_t)row * D + 16 * lane + 8) = w1;
                }
            }
            grid.sync();
            if (PH(10)) {
                pg8::Gemm g{Hb, WOB, M, D, D}; pg8::StaticOrder So; So.init(M, D, G, bx);
                pg8::EpiY E{Y, D, SSQ};
                pg8::gemm_phase<pg8::EpiY, pg8::StaticOrder, true, true>(lds, g, So, E);
            }
            grid.sync();
        }
        if (PH(11)) {
            const float* mm = MODS + (size_t)(2 * l) * 8 * 3072;
            const float* mf = MODS + (size_t)(2 * l + 1) * 8 * 3072;
            thin_pass<true, 1>(gw, NGW, lane, l == 0 ? x_in : out, out, Y, SSQ, norm_post_mix + l * D, mm + 2048,
                               norm_pre_ffn + l * D, mf + 1024, mf, Hb, nullptr, nullptr, nullptr, nullptr);
        }
        grid.sync();
        bf16_t* Ab = (bf16_t*)R;
        bf16_t* Fb = (bf16_t*)(R + 176 * MiB);
        if (PH(12)) {
            pg8::Gemm g{Hb, (const bf16_t*)(ws + (l ? WS_WG1 : WS_WG0)), M, FF, D}; pg8::StaticOrder So; So.init(M, FF, G, bx);
            pg8::EpiBf16P E{Ab, FF};
            pg8::gemm_phase<pg8::EpiBf16P, pg8::StaticOrder, true, true>(lds, g, So, E);
        }
        grid.sync();
        if (PH(13)) {
            pg8::Gemm g{Hb, (const bf16_t*)(ws + (l ? WS_WU1 : WS_WU0)), M, FF, D}; pg8::StaticOrder So; So.init(M, FF, G, bx);
            pg8::EpiUpConv E{Ab, Fb, ffn_conv_w + (size_t)l * 3 * FF, ffn_conv_b + (size_t)l * FF, FF};
            pg8::gemm_phase<pg8::EpiUpConv, pg8::StaticOrder, true, true>(lds, g, So, E);
        }
        grid.sync();
        if (PH(14)) {
            pg8::Gemm g{Fb, (const bf16_t*)(ws + (l ? WS_WD1 : WS_WD0)), M, D, FF}; pg8::StaticOrder So; So.init(M, D, G, bx);
            pg8::EpiY E{Y, D, SSQ};
            pg8::gemm_phase<pg8::EpiY, pg8::StaticOrder, true, true>(lds, g, So, E);
        }
        grid.sync();
        if (PH(15)) {
            const float* mf = MODS + (size_t)(2 * l + 1) * 8 * 3072;
            if (l == 0) {
                const float* mm1 = MODS + (size_t)2 * 8 * 3072; const float* mkv = MODS + (size_t)4 * 8 * 3072;
                thin_pass<true, 2>(gw, NGW, lane, out, out, Y, SSQ, norm_post_ffn, mf + 2048,
                                   norm_pre_mix + D, mm1 + 1024, mm1, Hb, kv_norm, mkv + 1024, mkv, (bf16_t*)(R + 128 * MiB));
                grid.sync();
            } else {
                thin_pass<true, 0>(gw, NGW, lane, out, out, Y, SSQ, norm_post_ffn + D, mf + 2048,
                                   nullptr, nullptr, nullptr, nullptr, nullptr, nullptr, nullptr, nullptr);
            }
        }
    }
}

extern "C" void kernel_launch(void* const* d_in, const int* in_sizes, int n_in, void* d_out, int out_size, void* d_ws, size_t ws_size, hipStream_t stream) {
    static int grid = 0;
    if (grid == 0) {
        if (n_in != 30 || out_size != M * D || ws_size < WS_END) { fprintf(stderr, "kernel_launch: unexpected shapes (n_in %d out %d ws %zu)\n", n_in, out_size, ws_size); grid = -1; return; }
        int dev = 0, cus = 0, per_cu = 0;
        (void)hipGetDevice(&dev);
        (void)hipDeviceGetAttribute(&cus, hipDeviceAttributeMultiprocessorCount, dev);
        (void)hipFuncSetAttribute((const void*)mk_fwd, hipFuncAttributeMaxDynamicSharedMemorySize, LDS_BYTES);
        (void)hipOccupancyMaxActiveBlocksPerMultiprocessor(&per_cu, (const void*)mk_fwd, 512, LDS_BYTES);
        if (per_cu < 1) per_cu = 1;
        grid = cus * per_cu;
    }
    if (grid < 0) return;
    Args a{};
    for (int i = 0; i < 30; ++i) a.in[i] = d_in[i];
    a.out = (float*)d_out; a.ws = (unsigned char*)d_ws;
    void* args[] = {&a};
    hipError_t e = hipLaunchCooperativeKernel((const void*)mk_fwd, dim3(grid), dim3(512), args, LDS_BYTES, stream);
    if (e != hipSuccess) fprintf(stderr, "cooperative launch failed: %s (grid %d)\n", hipGetErrorString(e), grid);
}
```

```cpp
#include <hip/hip_runtime.h>
#include <hip/hip_cooperative_groups.h>
#include <cstdio>
#include <cstdint>
#include <type_traits>
namespace cg = cooperative_groups;
constexpr float QSCALE = 0.125f * 1.4426950408889634f;
namespace pg8 {
#define PG8_LAS __attribute__((address_space(3)))
typedef unsigned short bf16_t;
typedef short bf16x8 __attribute__((ext_vector_type(8)));
typedef float f32x4 __attribute__((ext_vector_type(4)));
typedef unsigned u32x4 __attribute__((ext_vector_type(4)));
constexpr int BM = 256, BK = 64, HALF = 128, HTB = HALF * BK * 2  , STAGE_BYTES = 8 * HTB, NXCD = 8, WGM = 8;

__host__ __device__ __forceinline__ int lds_byte(int r, int c) { const int st = (r >> 4) * 2 + (c >> 5), rr = r & 15, cc = c & 31, ob = rr * 64 + cc * 2; return st * 1024 + (ob ^ (((ob >> 9) & 1) << 5)); }
__host__ __device__ __forceinline__ void stage_rc(int b, int& R, int& C) { const int st = b / 1024, sb = b % 1024, swz = sb ^ (((sb >> 9) & 1) << 5); R = (st >> 1) * 16 + swz / 64; C = (st & 1) * 32 + (swz % 64) / 2; }
__host__ __device__ __forceinline__ int perm32(int rho) { const int n = rho >> 4, i = rho & 15; return 8 * (i >> 2) + 4 * n + (i & 3); }

struct Unit { int pm, pn; };
struct Gemm { const bf16_t* A; const bf16_t* Bt; int M, N, K; };

struct StaticOrder {
    int nM, nN, nwg, G, c;
    __host__ __device__ void init(int M, int N, int G_, int c_) { nM = M / BM; nN = N / BM; nwg = nM * nN; G = G_; c = c_; }
    __host__ __device__ bool next(int i, Unit& u) const {
        const long L = (long)i * G + c; if (L >= nwg) return false;
        int wgid = (int)L; { const int q = nwg / NXCD, r = nwg % NXCD, xcd = wgid % NXCD, off = wgid / NXCD; wgid = (xcd < r ? xcd * (q + 1) : r * (q + 1) + (xcd - r) * q) + off; }
        const int nig = WGM * nN, gid = wgid / nig, fm = gid * WGM, gsz = (nM - fm) < WGM ? (nM - fm) : WGM;
        u.pm = fm + ((wgid % nig) % gsz); u.pn = (wgid % nig) / gsz; return true;
    }
    __device__ __forceinline__ void a_ready(const Unit&) const {}
    __device__ __forceinline__ void done(const Unit&) const {}
};
__device__ __forceinline__ unsigned cvt_pk_bf16(float lo, float hi) { unsigned r; asm volatile("v_cvt_pk_bf16_f32 %0, %1, %2" : "=v"(r) : "v"(lo), "v"(hi)); return r; }
typedef float f32x2 __attribute__((ext_vector_type(2)));
typedef unsigned u32x2 __attribute__((ext_vector_type(2)));
__device__ __forceinline__ void st16_wt(void* p, u32x4 v) { asm volatile("global_store_dwordx4 %0, %1, off sc1\n\ts_nop 2" : : "v"(p), "v"(v) : "memory"); }
struct EpiBf16P {
    static constexpr bool PERM = true, AFTER_DRAIN = false;
    bf16_t* O; int ldc;
    __device__ __forceinline__ void operator()(const f32x4 (&acc)[2][2][4][2], const Unit& u, int wr, int wc, int fr, int fq) const {
        const int row0 = u.pm * BM + wr * 64 + fr, col0 = u.pn * BM + wc * 32 + 8 * fq;
#pragma unroll
        for (int ai = 0; ai < 2; ++ai)
#pragma unroll
            for (int m = 0; m < 4; ++m) { bf16_t* rowp = O + (size_t)(row0 + ai * HALF + m * 16) * ldc + col0;
#pragma unroll
                for (int bj = 0; bj < 2; ++bj) { const f32x4 v0 = acc[ai][bj][m][0], v1 = acc[ai][bj][m][1];
                    u32x4 w; w.x = cvt_pk_bf16(v0[0], v0[1]); w.y = cvt_pk_bf16(v0[2], v0[3]); w.z = cvt_pk_bf16(v1[0], v1[1]); w.w = cvt_pk_bf16(v1[2], v1[3]);
                    *(u32x4*)(rowp + bj * HALF) = w; } }
    }
};
template <int MODE> struct EpiRope {
    static constexpr bool PERM = true, AFTER_DRAIN = false;
    bf16_t* O; int ldc; const float* rope; size_t split_stride;
    __device__ __forceinline__ void operator()(const f32x4 (&acc)[2][2][4][2], const Unit& u, int wr, int wc, int fr, int fq) const {
        const int colt = u.pn * BM;
        bool rot = true; float sc = 1.f; int dsh = 0; bf16_t* base = O; int ct = colt;
        if (MODE == 0) { const int g = colt / 1536, t = (colt % 1536) / 512; rot = t < 2; sc = (t == 0) ? QSCALE : 1.f; dsh = 2 * g; }
        else if (MODE == 1) { rot = colt < 1024; if (!rot) { base += split_stride; ct -= 1024; } }
        else { sc = QSCALE; }
        const int col0 = ct + wc * 32 + 8 * fq;
        const bool dorot = rot && ((wc & 1) == 0) && (fq < 2);
#pragma unroll
        for (int ai = 0; ai < 2; ++ai)
#pragma unroll
            for (int m = 0; m < 4; ++m) {
                const int row = u.pm * BM + ai * HALF + wr * 64 + m * 16 + fr;
                int orow = row;
                if (MODE == 0 && dsh > 0) { const int b = row >> 12, s = row & 4095; orow = (b << 12) + ((s & ((1 << dsh) - 1)) << (12 - dsh)) + (s >> dsh); }
                f32x4 cs0 = (f32x4){1.f, 0.f, 1.f, 0.f}, cs1 = (f32x4){1.f, 0.f, 1.f, 0.f};
                if (dorot) { const f32x4* rp = (const f32x4*)(rope + (size_t)row * 16 + fq * 8); cs0 = rp[0]; cs1 = rp[1]; }
                bf16_t* rowp = base + (size_t)orow * ldc + col0;
#pragma unroll
                for (int bj = 0; bj < 2; ++bj) { f32x4 v0 = acc[ai][bj][m][0], v1 = acc[ai][bj][m][1];
                    if (dorot) {
                        const f32x4 a = v0, b = v1;
                        v0[0] = a[0] * cs0[0] - a[1] * cs0[1]; v0[1] = a[1] * cs0[0] + a[0] * cs0[1];
                        v0[2] = a[2] * cs0[2] - a[3] * cs0[3]; v0[3] = a[3] * cs0[2] + a[2] * cs0[3];
                        v1[0] = b[0] * cs1[0] - b[1] * cs1[1]; v1[1] = b[1] * cs1[0] + b[0] * cs1[1];
                        v1[2] = b[2] * cs1[2] - b[3] * cs1[3]; v1[3] = b[3] * cs1[2] + b[2] * cs1[3];
                    }
                    v0 = v0 * sc; v1 = v1 * sc;
                    u32x4 w; w.x = cvt_pk_bf16(v0[0], v0[1]); w.y = cvt_pk_bf16(v0[2], v0[3]); w.z = cvt_pk_bf16(v1[0], v1[1]); w.w = cvt_pk_bf16(v1[2], v1[3]);
                    if (MODE == 0) __builtin_nontemporal_store(w, (u32x4*)(rowp + bj * HALF)); else st16_wt(rowp + bj * HALF, w); }
            }
    }
};
struct EpiY {
    static constexpr bool PERM = true, AFTER_DRAIN = false;
    bf16_t* Y; int ldc; float* ssq;
    __device__ __forceinline__ void operator()(const f32x4 (&acc)[2][2][4][2], const Unit& u, int wr, int wc, int fr, int fq) const {
        const int col0 = u.pn * BM + wc * 32 + 8 * fq;
#pragma unroll
        for (int ai = 0; ai < 2; ++ai)
#pragma unroll
            for (int m = 0; m < 4; ++m) {
                const int row = u.pm * BM + ai * HALF + wr * 64 + m * 16 + fr;
                bf16_t* rowp = Y + (size_t)row * ldc + col0; float s = 0.f;
#pragma unroll
                for (int bj = 0; bj < 2; ++bj) { const f32x4 v0 = acc[ai][bj][m][0], v1 = acc[ai][bj][m][1];
                    s += ((v0[0] * v0[0] + v0[1] * v0[1]) + (v0[2] * v0[2] + v0[3] * v0[3])) + ((v1[0] * v1[0] + v1[1] * v1[1]) + (v1[2] * v1[2] + v1[3] * v1[3]));
                    u32x4 w; w.x = cvt_pk_bf16(v0[0], v0[1]); w.y = cvt_pk_bf16(v0[2], v0[3]); w.z = cvt_pk_bf16(v1[0], v1[1]); w.w = cvt_pk_bf16(v1[2], v1[3]);
                    st16_wt(rowp + bj * HALF, w); }
                s += __shfl_xor(s, 16); s += __shfl_xor(s, 32);
                if (fq == 0) ssq[(size_t)row * 16 + u.pn * 4 + wc] = s;
            }
    }
};
struct EpiUpConv {
    static constexpr bool PERM = true, AFTER_DRAIN = false;
    const bf16_t* A; bf16_t* Fo; const float* cw; const float* cb; int ff;
    __device__ __forceinline__ void operator()(const f32x4 (&acc)[2][2][4][2], const Unit& u, int wr, int wc, int fr, int fq) const {
        const int row0 = u.pm * BM + wr * 64 + fr;
#pragma unroll
        for (int bj = 0; bj < 2; ++bj) {
            const int col = u.pn * BM + bj * HALF + wc * 32 + 8 * fq;
            float w0[8], w1[8], w2[8], bb[8];
#pragma unroll
            for (int h = 0; h < 2; ++h) { const f32x4 t0 = *(const f32x4*)(cw + col + 4 * h), t1 = *(const f32x4*)(cw + ff + col + 4 * h), t2 = *(const f32x4*)(cw + 2 * ff + col + 4 * h), t3 = *(const f32x4*)(cb + col + 4 * h);
#pragma unroll
                for (int e = 0; e < 4; ++e) { w0[4 * h + e] = t0[e]; w1[4 * h + e] = t1[e]; w2[4 * h + e] = t2[e]; bb[4 * h + e] = t3[e]; } }
#pragma unroll
            for (int ai = 0; ai < 2; ++ai)
#pragma unroll
                for (int m = 0; m < 4; ++m) {
                    const int row = row0 + ai * HALF + m * 16; const int s = row & 4095;
                    const bf16_t* ap = A + (size_t)row * ff + col;
                    const u32x4 z = (u32x4){0u, 0u, 0u, 0u};
                    const u32x4 a2 = *(const u32x4*)ap;
                    const u32x4 a1 = (s >= 1) ? *(const u32x4*)(ap - ff) : z;
                    const u32x4 a0 = (s >= 2) ? *(const u32x4*)(ap - 2 * ff) : z;
                    float f[8];
#pragma unroll
                    for (int e = 0; e < 8; ++e) {
                        const unsigned x0 = a0[e >> 1], x1 = a1[e >> 1], x2 = a2[e >> 1];
                        const float f0 = __uint_as_float((e & 1) ? (x0 & 0xffff0000u) : (x0 << 16));
                        const float f1 = __uint_as_float((e & 1) ? (x1 & 0xffff0000u) : (x1 << 16));
                        const float f2 = __uint_as_float((e & 1) ? (x2 & 0xffff0000u) : (x2 << 16));
                        const float cv = bb[e] + w0[e] * f0 + w1[e] * f1 + w2[e] * f2;
                        const float zz = 1.5957691216057308f * (cv + 0.044715f * cv * cv * cv);
                        const float ex = __builtin_amdgcn_exp2f(-1.4426950408889634f * zz);
                        const float gl = cv * __builtin_amdgcn_rcpf(1.0f + ex);
                        f[e] = gl * acc[ai][bj][m][e >> 2][e & 3];
                    }
                    u32x4 w; w.x = cvt_pk_bf16(f[0], f[1]); w.y = cvt_pk_bf16(f[2], f[3]); w.z = cvt_pk_bf16(f[4], f[5]); w.w = cvt_pk_bf16(f[6], f[7]);
                    *(u32x4*)(Fo + (size_t)row * ff + col) = w;
                }
        }
    }
};

__device__ __forceinline__ float dpp_shr1(float v) { return __int_as_float(__builtin_amdgcn_update_dpp(0, __float_as_int(v), 0x111, 0xf, 0xf, true)); }
__device__ __forceinline__ float gelu_tanh_f(float cv) {
    const float zz = 1.5957691216057308f * (cv + 0.044715f * cv * cv * cv);
    const float ex = __builtin_amdgcn_exp2f(-1.4426950408889634f * zz);
    return cv * __builtin_amdgcn_rcpf(1.0f + ex);
}
__device__ __forceinline__ f32x4 gelu_mul4(f32x4 x, f32x4 u) {
    const f32x4 t = (x * x) * (-0.10294324f) + (-2.3022082f);
    const f32x4 z = x * t;
    f32x4 e; e[0] = __builtin_amdgcn_exp2f(z[0]); e[1] = __builtin_amdgcn_exp2f(z[1]); e[2] = __builtin_amdgcn_exp2f(z[2]); e[3] = __builtin_amdgcn_exp2f(z[3]);
    const f32x4 d = e + 1.0f;
    f32x4 r; r[0] = __builtin_amdgcn_rcpf(d[0]); r[1] = __builtin_amdgcn_rcpf(d[1]); r[2] = __builtin_amdgcn_rcpf(d[2]); r[3] = __builtin_amdgcn_rcpf(d[3]);
    return (x * u) * r;
}
struct EpiGateUp {
    static constexpr bool PERM = true, AFTER_DRAIN = false;
    bf16_t* Fo; const float* cw; const float* cb; int ff; float* bnd; float* halo;
    __device__ __forceinline__ void operator()(const f32x4 (&acc)[2][2][4][2], const Unit& u, int wr, int wc, int fr, int fq) const {
        const int cbase = u.pn * HALF + wc * 32 + 8 * fq;
        const int chunk = 2 * u.pm + wr;
        const int T0 = chunk * 128 + 8 * fr;
        unsigned fo[8][4];
#pragma unroll
        for (int n = 0; n < 2; ++n) {
            const f32x4 w0 = *(const f32x4*)(cw + cbase + 4 * n), w1 = *(const f32x4*)(cw + ff + cbase + 4 * n), w2 = *(const f32x4*)(cw + 2 * ff + cbase + 4 * n), bb = *(const f32x4*)(cb + cbase + 4 * n);
            f32x4 am2, am1;
#pragma unroll
            for (int e = 0; e < 4; ++e) { am2[e] = dpp_shr1(acc[1][0][2][n][e]); am1[e] = dpp_shr1(acc[1][0][3][n][e]); }
#pragma unroll
            for (int j = 0; j < 8; ++j) {
                const f32x4 aj = acc[j >> 2][0][j & 3][n], uj = acc[j >> 2][1][j & 3][n];
                const f32x4 cv = bb + w0 * am2 + w1 * am1 + w2 * aj;
                const f32x4 f = gelu_mul4(cv, uj);
                fo[j][2 * n] = cvt_pk_bf16(f[0], f[1]); fo[j][2 * n + 1] = cvt_pk_bf16(f[2], f[3]);
                am2 = am1; am1 = aj;
            }
            if (fr == 0) {
#pragma unroll
                for (int j = 0; j < 2; ++j) { *(f32x4*)(bnd + ((size_t)(chunk * 2 + j) * 2 + 0) * ff + cbase + 4 * n) = acc[0][0][j][n]; *(f32x4*)(bnd + ((size_t)(chunk * 2 + j) * 2 + 1) * ff + cbase + 4 * n) = acc[0][1][j][n]; }
            }
            if (fr == 15) {
#pragma unroll
                for (int j = 0; j < 2; ++j) *(f32x4*)(halo + (size_t)(chunk * 2 + j) * ff + cbase + 4 * n) = acc[1][0][2 + j][n];
            }
        }
#pragma unroll
        for (int j = 0; j < 8; ++j) {
            if (!(fr == 0 && j < 2)) { u32x4 w; w.x = fo[j][0]; w.y = fo[j][1]; w.z = fo[j][2]; w.w = fo[j][3]; st16_wt(Fo + (size_t)(T0 + j) * ff + cbase, w); }
        }
    }
};
template <class Epi, class Sched, bool ALIGN_EPI = false, bool SP2 = false>
__device__ __forceinline__ void gemm_phase(PG8_LAS unsigned char* lds, const Gemm g, const Sched& S, const Epi& E) {
    int tid_l = threadIdx.x; asm volatile("" : "+v"(tid_l));
    const int tid = tid_l, wid = __builtin_amdgcn_readfirstlane(tid >> 6), lane = tid & 63, wr = wid >> 2, wc = wid & 3, fr = lane & 15, fq = lane >> 4;
    const int K = g.K, nt = K / BK;
    unsigned voffA[2], voffB[2];
#pragma unroll
    for (int i = 0; i < 2; ++i) { int R, C; stage_rc(tid * 16 + i * 8192, R, C); const int Rb = Epi::PERM ? ((R & ~31) + perm32(R & 31)) : R;
        voffA[i] = (unsigned)(R * K + C) * 2u; voffB[i] = (unsigned)(Rb * K + C) * 2u; }
    const size_t kstep = (size_t)(BK * 2);
    const size_t hstep = (size_t)HALF * K * 2;
    const size_t tstep = 2 * hstep;
    const unsigned ldsw = (unsigned)wid * 1024u;
    const int aoff = lds_byte(wr * 64 + fr, fq * 8), boff = lds_byte(wc * 32 + fr, fq * 8);
#define PG8_SA(b, h) (((b) * 2 + (h)) * HTB)
#define PG8_SB(b, h) ((4 + (b) * 2 + (h)) * HTB)
#define PG8_STAGE(bufoff, gbase, voff) do { _Pragma("unroll") for (int _i = 0; _i < 2; ++_i) \
        __builtin_amdgcn_global_load_lds((const unsigned*)((const char*)(gbase) + (voff)[_i]), (PG8_LAS unsigned*)(lds + (bufoff) + ldsw + _i * 8192), 16, 0, 0); } while (0)
#define PG8_LDA(dst, b, h) do { _Pragma("unroll") for (int m = 0; m < 4; ++m) _Pragma("unroll") for (int k = 0; k < 2; ++k) dst[m][k] = *(const PG8_LAS bf16x8*)(lds + PG8_SA(b, h) + aoff + m * 2048 + k * 1024); } while (0)
#define PG8_LDB(dst, b, h) do { _Pragma("unroll") for (int n = 0; n < 2; ++n) _Pragma("unroll") for (int k = 0; k < 2; ++k) dst[n][k] = *(const PG8_LAS bf16x8*)(lds + PG8_SB(b, h) + boff + n * 2048 + k * 1024); } while (0)
#define PG8_MMA(ai, bj, At, Bt) do { __builtin_amdgcn_s_setprio(1); _Pragma("unroll") for (int m = 0; m < 4; ++m) _Pragma("unroll") for (int n = 0; n < 2; ++n) _Pragma("unroll") for (int k = 0; k < 2; ++k) \
        acc[ai][bj][m][n] = __builtin_amdgcn_mfma_f32_16x16x32_bf16(Bt[n][k], At[m][k], acc[ai][bj][m][n], 0, 0, 0); __builtin_amdgcn_s_setprio(0); } while (0)
#define PG8_WAIT_V(n) asm volatile("s_waitcnt vmcnt(" #n ")" ::: "memory")
#define PG8_WAIT_L(n) asm volatile("s_waitcnt lgkmcnt(" #n ")" ::: "memory")
#define PG8_BAR __builtin_amdgcn_s_barrier()
#define PG8_SCHED __builtin_amdgcn_sched_barrier(0)
    Unit cur, nxt; int ui = 0;
    if (!S.next(0, cur)) return;
    f32x4 acc[2][2][4][2];
#pragma unroll
    for (int a = 0; a < 2; ++a)
#pragma unroll
        for (int b = 0; b < 2; ++b)
#pragma unroll
            for (int m = 0; m < 4; ++m)
#pragma unroll
                for (int n = 0; n < 2; ++n) acc[a][b][m][n] = (f32x4){0.f, 0.f, 0.f, 0.f};
    bf16x8 At[4][2], B0[2][2], B1[2][2];
    const char* cA = (const char*)g.A + (size_t)cur.pm * tstep; const char* cB = (const char*)g.Bt + (size_t)cur.pn * tstep;
    S.a_ready(cur);
    if constexpr (SP2) {
        PG8_STAGE(PG8_SB(0, 0), cB, voffB); PG8_STAGE(PG8_SB(0, 1), cB + hstep, voffB); PG8_STAGE(PG8_SA(0, 0), cA, voffA); PG8_STAGE(PG8_SA(0, 1), cA + hstep, voffA);
        if (wr == 1) PG8_BAR;
        PG8_WAIT_V(2); PG8_BAR;
        PG8_STAGE(PG8_SB(1, 0), cB + kstep, voffB); PG8_STAGE(PG8_SA(1, 0), cA + kstep, voffA); PG8_STAGE(PG8_SB(1, 1), cB + hstep + kstep, voffB);
        PG8_WAIT_V(6); PG8_BAR;
    } else {
        PG8_STAGE(PG8_SB(0, 0), cB, voffB); PG8_STAGE(PG8_SA(0, 0), cA, voffA); PG8_STAGE(PG8_SB(0, 1), cB + hstep, voffB); PG8_STAGE(PG8_SA(0, 1), cA + hstep, voffA);
        if (wr == 1) PG8_BAR;
        PG8_WAIT_V(4); PG8_BAR;
        PG8_STAGE(PG8_SB(1, 0), cB + kstep, voffB); PG8_STAGE(PG8_SA(1, 0), cA + kstep, voffA); PG8_STAGE(PG8_SB(1, 1), cB + hstep + kstep, voffB);
        PG8_WAIT_V(6); PG8_BAR;
    }
    for (;;) {
        const bool has_next = S.next(ui + 1, nxt);
        const char* nA = has_next ? (const char*)g.A + (size_t)nxt.pm * tstep : cA; const char* nB = has_next ? (const char*)g.Bt + (size_t)nxt.pn * tstep : cB;
        for (int t = 0; t < nt; t += 2) {
            const bool last = (t == nt - 2);
            const char* a1 = cA + (size_t)(t + 1) * kstep;
            const char* a2 = last ? nA : cA + (size_t)(t + 2) * kstep; const char* b2 = last ? nB : cB + (size_t)(t + 2) * kstep;
            const char* a3 = a2 + kstep; const char* b3 = b2 + kstep;
            if (last && has_next) S.a_ready(nxt);
            if constexpr (SP2) {
            PG8_LDB(B0, 0, 0); PG8_LDB(B1, 0, 1); PG8_SCHED; PG8_LDA(At, 0, 0); PG8_STAGE(PG8_SA(1, 1), a1 + hstep, voffA);
            PG8_WAIT_V(8); PG8_WAIT_L(0); PG8_BAR; PG8_MMA(0, 0, At, B0); PG8_MMA(0, 1, At, B1); PG8_BAR; PG8_SCHED;
            PG8_LDA(At, 0, 1); PG8_STAGE(PG8_SB(0, 0), b2, voffB); PG8_STAGE(PG8_SB(0, 1), b2 + hstep, voffB); PG8_STAGE(PG8_SA(0, 0), a2, voffA);
            PG8_WAIT_V(8); PG8_WAIT_L(0); PG8_BAR; PG8_MMA(1, 0, At, B0); PG8_MMA(1, 1, At, B1); PG8_BAR; PG8_SCHED;
            PG8_LDB(B0, 1, 0); PG8_LDB(B1, 1, 1); PG8_SCHED; PG8_LDA(At, 1, 0); PG8_STAGE(PG8_SA(0, 1), a2 + hstep, voffA);
            PG8_WAIT_V(8); PG8_WAIT_L(0); PG8_BAR; PG8_MMA(0, 0, At, B0); PG8_MMA(0, 1, At, B1); PG8_BAR; PG8_SCHED;
            PG8_LDA(At, 1, 1); PG8_STAGE(PG8_SB(1, 0), b3, voffB); PG8_STAGE(PG8_SB(1, 1), b3 + hstep, voffB); PG8_STAGE(PG8_SA(1, 0), a3, voffA);
            PG8_WAIT_V(8); PG8_WAIT_L(0); PG8_BAR; PG8_MMA(1, 0, At, B0); PG8_MMA(1, 1, At, B1); PG8_BAR; PG8_SCHED;
            } else {
            PG8_LDB(B0, 0, 0); PG8_SCHED; PG8_LDA(At, 0, 0); PG8_STAGE(PG8_SA(1, 1), a1 + hstep, voffA);
            PG8_WAIT_L(8); PG8_BAR; PG8_WAIT_L(0); PG8_MMA(0, 0, At, B0); PG8_BAR; PG8_SCHED;
            PG8_LDB(B1, 0, 1); PG8_STAGE(PG8_SB(0, 0), b2, voffB);
            PG8_BAR; PG8_WAIT_L(0); PG8_MMA(0, 1, At, B1); PG8_BAR;
            PG8_LDA(At, 0, 1); PG8_STAGE(PG8_SA(0, 0), a2, voffA);
            PG8_BAR; PG8_WAIT_L(0); PG8_MMA(1, 0, At, B0); PG8_BAR; PG8_SCHED;
            PG8_STAGE(PG8_SB(0, 1), b2 + hstep, voffB);
            PG8_WAIT_V(6); PG8_BAR; PG8_MMA(1, 1, At, B1); PG8_BAR;
            PG8_LDB(B0, 1, 0); PG8_SCHED; PG8_LDA(At, 1, 0); PG8_STAGE(PG8_SA(0, 1), a2 + hstep, voffA);
            PG8_WAIT_L(8); PG8_BAR; PG8_WAIT_L(0); PG8_MMA(0, 0, At, B0); PG8_BAR; PG8_SCHED;
            PG8_LDB(B1, 1, 1); PG8_STAGE(PG8_SB(1, 0), b3, voffB);
            PG8_BAR; PG8_WAIT_L(0); PG8_MMA(0, 1, At, B1); PG8_BAR;
            PG8_LDA(At, 1, 1); PG8_STAGE(PG8_SA(1, 0), a3, voffA);
            PG8_BAR; PG8_WAIT_L(0); PG8_MMA(1, 0, At, B0); PG8_BAR; PG8_SCHED;
            PG8_STAGE(PG8_SB(1, 1), b3 + hstep, voffB);
            PG8_WAIT_V(6); PG8_BAR; PG8_MMA(1, 1, At, B1); PG8_BAR;
            }
        }
        if constexpr (ALIGN_EPI) { if (wr == 0) PG8_BAR; }
        if constexpr (!Epi::AFTER_DRAIN) { E(acc, cur, wr, wc, fr, fq); S.done(cur); }
        if (!has_next) break;
#pragma unroll
        for (int a = 0; a < 2; ++a)
#pragma unroll
            for (int b = 0; b < 2; ++b)
#pragma unroll
                for (int m = 0; m < 4; ++m)
#pragma unroll
                    for (int n = 0; n < 2; ++n) acc[a][b][m][n] = (f32x4){0.f, 0.f, 0.f, 0.f};
        cur = nxt; cA = nA; cB = nB; ++ui;
        if constexpr (ALIGN_EPI) { if (wr == 1) PG8_BAR; }
    }
    PG8_WAIT_V(0);
    if constexpr (!ALIGN_EPI) { if (wr == 0) PG8_BAR; }
    PG8_BAR;
    if constexpr (Epi::AFTER_DRAIN) { E.fused(acc, cur, wr, wc, fr, fq, lds, wid, lane); S.done(cur); }
#undef PG8_SA
#undef PG8_SB
#undef PG8_STAGE
#undef PG8_LDA
#undef PG8_LDB
#undef PG8_MMA
#undef PG8_WAIT_V
#undef PG8_WAIT_L
#undef PG8_BAR
#undef PG8_SCHED
}
}
#define LAS __attribute__((address_space(3)))
typedef unsigned short bf16_t;
typedef short bf16x8 __attribute__((ext_vector_type(8)));
typedef short s16x4 __attribute__((ext_vector_type(4)));
typedef float f32x4 __attribute__((ext_vector_type(4)));
typedef float f32x16 __attribute__((ext_vector_type(16)));
typedef unsigned u32x4 __attribute__((ext_vector_type(4)));
typedef unsigned u32x2 __attribute__((ext_vector_type(2)));
using pg8::cvt_pk_bf16;

constexpr int NB = 8, S = 4096, D = 1024, M = NB * S, FF = 2816, NQKV = 4608;
constexpr float LAM_INIT = 0.35550906759096934f;
constexpr size_t MiB = 1u << 20;
constexpr size_t WS_MODS = 0, WS_ROPE = 1 * MiB, WS_SSQ = 3 * MiB, WS_LSE = 5 * MiB;
constexpr size_t WS_WQKV = 8 * MiB, WS_WOA = 17 * MiB, WS_WG0 = 18 * MiB, WS_WU0 = WS_WG0 + 5767168, WS_WD0 = WS_WU0 + 5767168, WS_WG1 = WS_WD0 + 5767168, WS_WU1 = WS_WG1 + 5767168, WS_WD1 = WS_WU1 + 5767168;
constexpr size_t WS_WKV = 53 * MiB, WS_WQ1 = 57 * MiB, WS_WOB = 59 * MiB;
static_assert(WS_WD1 + 5767168 <= WS_WKV && WS_WOB + 2 * MiB <= 64 * MiB, "weights map");
constexpr size_t WS_H = 64 * MiB, WS_R = 128 * MiB, WS_END = 512 * MiB;
constexpr int LDS_BYTES = 147456;
constexpr size_t WS_BAR = 507904, BAR_ZERO_BYTES = 16384;
constexpr int LDS_MISC = 131072 + 64;

__device__ __forceinline__ float wave_sum(float v) {
#pragma unroll
    for (int o = 1; o < 64; o <<= 1) v += __shfl_xor(v, o);
    return v;
}
__device__ __forceinline__ u32x4 pair16(u32x2 f, u32x2 s) {
    const auto r0 = __builtin_amdgcn_permlane32_swap(f.x, s.x, false, false); const auto r1 = __builtin_amdgcn_permlane32_swap(f.y, s.y, false, false);
    return (u32x4){r0[0], r1[0], r0[1], r1[1]};
}
__device__ __forceinline__ float bflo(unsigned w) { return __uint_as_float(w << 16); }
__device__ __forceinline__ float bfhi(unsigned w) { return __uint_as_float(w & 0xffff0000u); }

#define XB_TMO      128
#define XB_XCNT(j)  (256  + 64 * (j))
#define XB_XSUB(j)  (1280 + 64 * (j))
#define XB_XGEN(j)  (2304 + 64 * (j))
#define XB_TOP      3328
#define XB_TOPGEN   3392
#define XCD_BAR_WORDS 3456
#define XB_SPIN_CAP (1u << 18)

__device__ __forceinline__ unsigned xb_ld(unsigned* p)              { return __hip_atomic_load(p, __ATOMIC_RELAXED, __HIP_MEMORY_SCOPE_AGENT); }
__device__ __forceinline__ unsigned xb_add(unsigned* p, unsigned v) { return __hip_atomic_fetch_add(p, v, __ATOMIC_RELAXED, __HIP_MEMORY_SCOPE_AGENT); }
__device__ __forceinline__ unsigned xb_xcc_id() { return (unsigned)__builtin_amdgcn_s_getreg((3 << 11) | 20) & 0xFu; }
#define XB_SPIN(cond, bar) do { unsigned _sp = 0; while (cond) { __builtin_amdgcn_s_sleep(1); \
    if ((++_sp & 255u) == 0u) { if (xb_ld(&(bar)[XB_TMO])) break; if (_sp > XB_SPIN_CAP) { atomicAdd(&(bar)[XB_TMO], 1u); break; } } } } while (0)

struct XcdBarrier {
    unsigned* bar; unsigned x;
    volatile LAS unsigned* st;
};

__device__ __forceinline__ XcdBarrier xcd_barrier_post(unsigned* bar, volatile LAS unsigned* st) {
    XcdBarrier b; b.bar = bar; b.x = xb_xcc_id(); b.st = st;
    if (threadIdx.x == 0) (void)xb_add(&bar[XB_XCNT(b.x)], 1u);
    return b;
}
__device__ __forceinline__ void xcd_barrier_complete(unsigned* bar, unsigned x, unsigned& nloc, unsigned& nx) {
    const unsigned G = gridDim.x * gridDim.y * gridDim.z;
    unsigned sum, cnt, mine, sp = 0u;
    for (;;) {
        sum = 0u; cnt = 0u; mine = 0u;
#pragma unroll
        for (unsigned j = 0; j < 16; ++j) { const unsigned c = xb_ld(&bar[XB_XCNT(j)]); sum += c; cnt += (c > 0u) ? 1u : 0u; mine = (j == x) ? c : mine; }
        if (sum == G) break;
        __builtin_amdgcn_s_sleep(1);
        if ((++sp & 255u) == 0u) { if (xb_ld(&bar[XB_TMO])) break; if (sp > XB_SPIN_CAP) { atomicAdd(&bar[XB_TMO], 1u); break; } }
    }
    nloc = mine > 0u ? mine : 1u; nx = cnt > 0u ? cnt : 1u;
}

__device__ __forceinline__ void xcd_barrier(const XcdBarrier& b) {
    asm volatile("s_waitcnt vmcnt(0)" ::: "memory");
    __syncthreads();
    if (threadIdx.x == 0) {
        unsigned* bar = b.bar;
        __builtin_amdgcn_s_waitcnt(0);
        unsigned nloc = b.st[0], nx = b.st[1];
        if (nloc == 0u) { xcd_barrier_complete(bar, b.x, nloc, nx); b.st[0] = nloc; b.st[1] = nx; }
        const unsigned old = xb_add(&bar[XB_XSUB(b.x)], 1u);
        const unsigned gen = old / nloc;
        if (old + 1u == (gen + 1u) * nloc) {
            __builtin_amdgcn_fence(__ATOMIC_RELEASE, "agent");
            asm volatile("s_waitcnt vmcnt(0)" ::: "memory");
            const unsigned og = xb_add(&bar[XB_TOP], 1u);
            const unsigned tg = og / nx;
            if (og + 1u == (tg + 1u) * nx) xb_add(&bar[XB_TOPGEN], 1u);
            else XB_SPIN(xb_ld(&bar[XB_TOPGEN]) == tg, bar);
            __builtin_amdgcn_fence(__ATOMIC_ACQUIRE, "agent");
            xb_add(&bar[XB_XGEN(b.x)], 1u);
            asm volatile("s_waitcnt vmcnt(0)" ::: "memory");
        } else {
            XB_SPIN(xb_ld(&bar[XB_XGEN(b.x)]) == gen, bar);
            __builtin_amdgcn_fence(__ATOMIC_ACQUIRE, "agent");
            asm volatile("s_waitcnt vmcnt(0)" ::: "memory");
        }
    }
    __syncthreads();
}

template <int DV, bool WINDOW>
__device__ __forceinline__ void attn_core(LAS unsigned char* lds, const bf16_t* Qp, size_t ldq, const bf16_t* Kp, size_t ldk, const bf16_t* Vp, size_t ldv, int i0,
                                          f32x16 (&o)[DV / 32], float& m_run, float& l_run) {
    constexpr int KROW = 144, VROW = DV * 2 + 64, KBYTES = 64 * KROW, VBYTES = 64 * VROW, STAGE = KBYTES + VBYTES, NV = DV / 64, NO = DV / 32;
    int tid_l = threadIdx.x; asm volatile("" : "+v"(tid_l));
    const int tid = tid_l, lane = tid & 63, wid = __builtin_amdgcn_readfirstlane(tid >> 6), r32 = lane & 31, hi = lane >> 5;
    const bf16_t* qrow = Qp + (size_t)(wid * 32 + r32) * ldq + hi * 8;
    bf16x8 qf[4];
#pragma unroll
    for (int d0 = 0; d0 < 4; ++d0) qf[d0] = *(const bf16x8*)(qrow + d0 * 16);
    const int qmin = i0 + wid * 32, qi = qmin + r32;
    const int t_lo = WINDOW ? (((i0 >> 6) - 2) > 0 ? ((i0 >> 6) - 2) : 0) : 0, t_hi = (i0 >> 6) + 4;
    const int wt_lo = WINDOW ? ((((qmin - 128) >> 6) > 0) ? ((qmin - 128) >> 6) : 0) : 0, wt_hi = ((qmin + 31) >> 6) + 1;
    const int skey = tid >> 3, sch = tid & 7;
    const bf16_t* kg = Kp + (size_t)skey * ldk + sch * 8;
    const bf16_t* vg = Vp + (size_t)skey * ldv + sch * 8;
    LAS unsigned char* ks = lds + skey * KROW + sch * 16;
    LAS unsigned char* vs = lds + KBYTES + skey * VROW + sch * 16;
    const LAS unsigned char* kr = lds + r32 * KROW + hi * 16;
    const LAS unsigned char* vr = lds + KBYTES + (4 * hi + ((lane & 15) >> 2)) * VROW + (((lane >> 4) & 1) * 16 + (lane & 3) * 4) * 2;
#pragma unroll
    for (int i = 0; i < NO; ++i)
#pragma unroll
        for (int r = 0; r < 16; ++r) o[i][r] = 0.f;
    float mr = 0.f, lr = 0.f; bool started = false;
    f32x16 negm;
#pragma unroll
    for (int r = 0; r < 16; ++r) negm[r] = 0.f;
    u32x4 kreg, vreg[NV];
    bf16x8 pf[4];
#pragma unroll
    for (int s = 0; s < 4; ++s) pf[s] = (bf16x8){0, 0, 0, 0, 0, 0, 0, 0};
#define ATT_SBAR() __builtin_amdgcn_sched_barrier(0)
#define ATT_GLOAD(t) do { kreg = *(const u32x4*)(kg + (size_t)(t) * 64 * ldk); _Pragma("unroll") for (int i_ = 0; i_ < NV; ++i_) vreg[i_] = *(const u32x4*)(vg + (size_t)(t) * 64 * ldv + i_ * 64); } while (0)
#define ATT_LSTORE(so) do { *(LAS u32x4*)(ks + (so)) = kreg; _Pragma("unroll") for (int i_ = 0; i_ < NV; ++i_) *(LAS u32x4*)(vs + (so) + i_ * 128) = vreg[i_]; } while (0)
#define ATT_VREAD2(dst, c_) do { _Pragma("unroll") for (int j_ = 0; j_ < 2; ++j_) { const int i_ = 2 * ((c_) % (NO / 2)) + j_; const LAS unsigned char* ap_ = vb_ + (16 * ((c_) / (NO / 2))) * VROW + i_ * 64; \
        const s16x4 lo_ = __builtin_bit_cast(s16x4, __builtin_amdgcn_ds_read_tr16_b64_v4i16((LAS s16x4*)ap_)); \
        const s16x4 h4_ = __builtin_bit_cast(s16x4, __builtin_amdgcn_ds_read_tr16_b64_v4i16((LAS s16x4*)(ap_ + 8 * VROW))); \
        dst[j_] = (bf16x8){lo_[0], lo_[1], lo_[2], lo_[3], h4_[0], h4_[1], h4_[2], h4_[3]}; } } while (0)
#define ATT_PV2(src, c_) do { _Pragma("unroll") for (int j_ = 0; j_ < 2; ++j_) { const int i_ = 2 * ((c_) % (NO / 2)) + j_; o[i_] = __builtin_amdgcn_mfma_f32_32x32x16_bf16(src[j_], pf[(c_) / (NO / 2)], o[i_], 0, 0, 0); } } while (0)
#define ATT_MFMA_C(dst, a_, b_, c_) asm volatile("v_mfma_f32_32x32x16_bf16 %0, %1, %2, %3" : "=&v"(dst) : "v"(a_), "v"(b_), "v"(c_))
#define ATT_SPART(so_) do { const LAS unsigned char* kb_ = kr + (so_); bf16x8 kf_[2][2]; \
        kf_[0][0] = *(const LAS bf16x8*)(kb_); kf_[0][1] = *(const LAS bf16x8*)(kb_ + 32 * KROW); \
        ATT_SBAR(); \
        _Pragma("unroll") for (int d0 = 0; d0 < 4; ++d0) { \
            if (d0 + 1 < 4) { kf_[(d0 + 1) & 1][0] = *(const LAS bf16x8*)(kb_ + (d0 + 1) * 32); kf_[(d0 + 1) & 1][1] = *(const LAS bf16x8*)(kb_ + 32 * KROW + (d0 + 1) * 32); } \
            ATT_SBAR(); \
            if (d0 == 0) { ATT_MFMA_C(p0, kf_[0][0], qf[0], negm); ATT_MFMA_C(p1, kf_[0][1], qf[0], negm); } \
            else { p0 = __builtin_amdgcn_mfma_f32_32x32x16_bf16(kf_[d0 & 1][0], qf[d0], p0, 0, 0, 0); p1 = __builtin_amdgcn_mfma_f32_32x32x16_bf16(kf_[d0 & 1][1], qf[d0], p1, 0, 0, 0); } \
            ATT_SBAR(); } } while (0)
#define ATT_PVPART(so_) do { const LAS unsigned char* vb_ = vr + (so_); bf16x8 vf_[2][2]; constexpr int NCH_ = 4 * (NO / 2); \
        ATT_VREAD2(vf_[0], 0); ATT_SBAR(); \
        _Pragma("unroll") for (int c_ = 0; c_ < NCH_; ++c_) { if (c_ + 1 < NCH_) { ATT_VREAD2(vf_[(c_ + 1) & 1], c_ + 1); } ATT_SBAR(); ATT_PV2(vf_[c_ & 1], c_); ATT_SBAR(); } } while (0)
#define ATT_SOFTMAX(t_) do { \
            const int tk = (t_) * 64; \
            const bool needmask = WINDOW ? !((tk + 63 <= qmin) && (tk >= qmin + 31 - 128)) : (tk + 63 > qmin); \
            if (needmask) { \
                _Pragma("unroll") for (int r = 0; r < 16; ++r) { \
                    const int kk = tk + 4 * hi + (r & 3) + 8 * (r >> 2); \
                    const bool ok0 = (kk <= qi) && (!WINDOW || kk >= qi - 128); \
                    const bool ok1 = (kk + 32 <= qi) && (!WINDOW || kk + 32 >= qi - 128); \
                    p0[r] = ok0 ? p0[r] : -1e30f; p1[r] = ok1 ? p1[r] : -1e30f; } } \
            float mx; { float ma = __builtin_fmaxf(__builtin_fmaxf(p0[0], p0[1]), p1[0]), mb = __builtin_fmaxf(__builtin_fmaxf(p0[2], p0[3]), p1[1]); ma = __builtin_fmaxf(__builtin_fmaxf(ma, p1[2]), p1[3]); \
              _Pragma("unroll") for (int r = 4; r < 16; r += 4) { ma = __builtin_fmaxf(__builtin_fmaxf(ma, p0[r]), p0[r + 1]); mb = __builtin_fmaxf(__builtin_fmaxf(mb, p0[r + 2]), p0[r + 3]); ma = __builtin_fmaxf(__builtin_fmaxf(ma, p1[r]), p1[r + 1]); mb = __builtin_fmaxf(__builtin_fmaxf(mb, p1[r + 2]), p1[r + 3]); } \
              mx = __builtin_fmaxf(ma, mb); } \
            { auto rr = __builtin_amdgcn_permlane32_swap(__float_as_uint(mx), __float_as_uint(mx), false, false); mx = fmaxf(__uint_as_float(rr[0]), __uint_as_float(rr[1])); } \
            if (!started) { started = true; mr = mx; _Pragma("unroll") for (int r = 0; r < 16; ++r) negm[r] = -mx; \
                _Pragma("unroll") for (int r = 0; r < 16; ++r) { p0[r] -= mx; p1[r] -= mx; } \
            } else if (__builtin_amdgcn_ballot_w64(mx > 8.0f) != 0ull) { \
                const float dl = (mx > 8.0f) ? mx : 0.f; mr += dl; _Pragma("unroll") for (int r = 0; r < 16; ++r) negm[r] = -mr; \
                const float alpha = __builtin_amdgcn_exp2f(-dl); lr *= alpha; \
                _Pragma("unroll") for (int r = 0; r < 16; ++r) { p0[r] -= dl; p1[r] -= dl; } \
                _Pragma("unroll") for (int i = 0; i < NO; ++i) _Pragma("unroll") for (int r = 0; r < 16; ++r) o[i][r] *= alpha; } \
            _Pragma("unroll") for (int r = 0; r < 16; ++r) { p0[r] = __builtin_amdgcn_exp2f(p0[r]); p1[r] = __builtin_amdgcn_exp2f(p1[r]); }     \
            { float sa = p0[0] + p1[0], sb = p0[1] + p1[1], sc = p0[2] + p1[2], sd = p0[3] + p1[3];                                               \
              _Pragma("unroll") for (int r = 4; r < 16; r += 4) { sa += p0[r] + p1[r]; sb += p0[r + 1] + p1[r + 1]; sc += p0[r + 2] + p1[r + 2]; sd += p0[r + 3] + p1[r + 3]; } \
              lr += (sa + sb) + (sc + sd); } \
            { u32x4 w; \
              w.x = cvt_pk_bf16(p0[0], p0[1]); w.y = cvt_pk_bf16(p0[2], p0[3]); w.z = cvt_pk_bf16(p0[4], p0[5]); w.w = cvt_pk_bf16(p0[6], p0[7]); pf[0] = __builtin_bit_cast(bf16x8, w); \
              w.x = cvt_pk_bf16(p0[8], p0[9]); w.y = cvt_pk_bf16(p0[10], p0[11]); w.z = cvt_pk_bf16(p0[12], p0[13]); w.w = cvt_pk_bf16(p0[14], p0[15]); pf[1] = __builtin_bit_cast(bf16x8, w); \
              w.x = cvt_pk_bf16(p1[0], p1[1]); w.y = cvt_pk_bf16(p1[2], p1[3]); w.z = cvt_pk_bf16(p1[4], p1[5]); w.w = cvt_pk_bf16(p1[6], p1[7]); pf[2] = __builtin_bit_cast(bf16x8, w); \
              w.x = cvt_pk_bf16(p1[8], p1[9]); w.y = cvt_pk_bf16(p1[10], p1[11]); w.z = cvt_pk_bf16(p1[12], p1[13]); w.w = cvt_pk_bf16(p1[14], p1[15]); pf[3] = __builtin_bit_cast(bf16x8, w); } \
            ATT_SBAR(); } while (0)
#ifndef LAGSEL
#define LAGSEL (wid >= 4)
#endif
    const bool lag = LAGSEL;
    ATT_GLOAD(t_lo); ATT_LSTORE(0);
    asm volatile("" : "+v"(qf[0]), "+v"(qf[1]), "+v"(qf[2]), "+v"(qf[3]));
    __syncthreads();
    int so_p = 2 * STAGE, so_c = 0, so_n = STAGE;
    bool pend = false;
    for (int t = t_lo; t < t_hi; ++t) {
        const bool more = (t + 1 < t_hi);
        if (more) ATT_GLOAD(t + 1);
        const bool inr = (t >= wt_lo && t < wt_hi);
        if (pend) { ATT_PVPART(so_p); }
#if defined(EXP_DUPS)
        if (inr) { f32x16 p0, p1; ATT_SPART(so_c); asm volatile("" : "+v"(p0), "+v"(p1)); ATT_SPART(so_c); ATT_SOFTMAX(t); }
#else
        if (inr) { f32x16 p0, p1; ATT_SPART(so_c); ATT_SOFTMAX(t); }
#endif
        if (!lag && inr) { ATT_PVPART(so_c); }
        pend = lag && inr;
        if (more) ATT_LSTORE(so_n);
        __syncthreads();
#if defined(EXP_DUPB)
        asm volatile("s_nop 0" ::: "memory"); __syncthreads();
#endif
        { const int tmp = so_p; so_p = so_c; so_c = so_n; so_n = tmp; }
    }
    if (pend) { ATT_PVPART(so_p); }
    __syncthreads();
#undef ATT_SBAR
#undef ATT_GLOAD
#undef ATT_LSTORE
#undef ATT_VREAD2
#undef ATT_PV2
#undef ATT_SPART
#undef ATT_MFMA_C
#undef ATT_PVPART
#undef ATT_SOFTMAX
    m_run = mr; l_run = lr + __shfl_xor(lr, 32);
}

#ifndef ONLY
#define PH(k) true
#else
#define PH(k) ((ONLY) == (k))
#endif
#ifndef DUP_K
#define DUP_K (-1)
#endif
#define GSYNC() do { xcd_barrier(xbar); if (DUP_K == 9) xcd_barrier(xbar); } while (0)
#define REP(k) for (int rep_ = 0; rep_ < ((DUP_K == (k)) ? 2 : 1); ++rep_)
#ifdef PROBE_R
#define STAMP(k) do { if (blockIdx.x == 0 && threadIdx.x == 0) ((unsigned long long*)(a.ws + 520192))[k] = __builtin_amdgcn_s_memrealtime(); } while (0)
#else
#define STAMP(k) do {} while (0)
#endif
struct Args { const void* in[30]; float* out; unsigned char* ws; };

__device__ __forceinline__ int permcol(int n, int pmode) {
    if (pmode == 3) return 256 * (n >> 7) + (n & 127);
    if (pmode == 4) return 256 * (n >> 7) + 128 + (n & 127);
    const bool rot = (pmode == 1) || (pmode == 2 && (n % 1536) < 1024);
    const int nn = n & 63;
    if (rot && nn < 16) return (n & ~63) + 2 * (nn & 7) + (nn >> 3);
    return n;
}
__device__ __forceinline__ void transpose_item(const float* W, int K, int N, bf16_t* WT, int row_off, int pmode, LAS float* scr, int item, int lane) {
    const int nblk = N / 32, kb = item / nblk, nb = item % nblk, k0 = 64 * kb, n0 = 32 * nb;
#pragma unroll
    for (int i = 0; i < 32; ++i) { const int kk = 2 * i + (lane >> 5); scr[kk * 33 + (lane & 31)] = __builtin_nontemporal_load(W + (size_t)(k0 + kk) * N + n0 + (lane & 31)); }
    asm volatile("s_waitcnt lgkmcnt(0)" ::: "memory");
    const int c = lane & 7;
#pragma unroll
    for (int j = 0; j < 4; ++j) { const int n = (lane >> 3) + 8 * j; const LAS float* s = scr + (8 * c) * 33 + n;
        u32x4 o; o.x = cvt_pk_bf16(s[0 * 33], s[1 * 33]); o.y = cvt_pk_bf16(s[2 * 33], s[3 * 33]); o.z = cvt_pk_bf16(s[4 * 33], s[5 * 33]); o.w = cvt_pk_bf16(s[6 * 33], s[7 * 33]);
        *(u32x4*)(WT + (size_t)(row_off + permcol(n0 + n, pmode)) * K + k0 + 8 * c) = o; }
    asm volatile("s_waitcnt lgkmcnt(0)" ::: "memory");
}

__device__ __forceinline__ f32x4 ld4(const float* p) { return *(const f32x4*)p; }

template <bool HAS_Y, int NH, bool PERMROWS = false, bool XIN_BF = false, bool XOUT_BF = false>
__device__ __forceinline__ void thin_pass(int gw, int NGW, int lane, const void* xin_v, void* xout_v, const bf16_t* Y, const float* ssqp,
                                          const float* gpost, const float* gate,
                                          const float* g1, const float* sc1, const float* sh1, bf16_t* H1,
                                          const float* g2, const float* sc2, const float* sh2, bf16_t* H2) {
    asm volatile("" : "+v"(lane));
    const int rpw = (M + NGW - 1) / NGW; const int r0 = gw * rpw; const int r1 = (r0 + rpw < M) ? (r0 + rpw) : M;
    int curb = -1; f32x4 GG[4], A1[4], B1[4], A2[4], B2[4];
    typedef typename std::conditional<XIN_BF, u32x2, f32x4>::type xraw_t;
    xraw_t xn[4]; u32x2 yn[4]; float pvn = 0.f;
#define TP_LOAD(row_) do { _Pragma("unroll") for (int j = 0; j < 4; ++j) { \
              \
            if (XIN_BF) xn[j] = __builtin_nontemporal_load((const xraw_t*)((const bf16_t*)xin_v + (size_t)(row_) * D + 4 * lane + 256 * j)); else xn[j] = __builtin_nontemporal_load((const xraw_t*)((const float*)xin_v + (size_t)(row_) * D + 4 * lane + 256 * j)); \
            if (HAS_Y) yn[j] = __builtin_nontemporal_load((const u32x2*)(Y + (size_t)(row_) * D + 4 * lane + 256 * j)); } \
        if (HAS_Y) pvn = (lane < 16) ? ssqp[(size_t)(row_) * 16 + lane] : 0.f; } while (0)
    if (r0 < r1) TP_LOAD(r0);
    for (int row = r0; row < r1; ++row) {
        const int b = row >> 12;
        if (b != curb) { curb = b;
#pragma unroll
            for (int j = 0; j < 4; ++j) { const int c = 4 * lane + 256 * j;
                if (HAS_Y) GG[j] = ld4(gpost + c) * ld4(gate + b * 3072 + c);
                if (NH >= 1) { A1[j] = ld4(g1 + c) * (ld4(sc1 + b * 3072 + c) + 1.0f); B1[j] = ld4(sh1 + b * 3072 + c); }
                if (NH >= 2) { A2[j] = ld4(g2 + c) * (ld4(sc2 + b * 3072 + c) + 1.0f); B2[j] = ld4(sh2 + b * 3072 + c); } } }
        xraw_t xc[4]; u32x2 yc[4]; const float pvc = pvn;
#pragma unroll
        for (int j = 0; j < 4; ++j) { xc[j] = xn[j]; yc[j] = yn[j]; }
        if (row + 1 < r1) TP_LOAD(row + 1);
        f32x4 x[4];
#pragma unroll
        for (int j = 0; j < 4; ++j) {
            if (XIN_BF) { const u32x2 xw = __builtin_bit_cast(u32x2, *(const u32x2*)&xc[j]); x[j] = (f32x4){bflo(xw.x), bfhi(xw.x), bflo(xw.y), bfhi(xw.y)}; }
            else x[j] = *(const f32x4*)&xc[j];
        }
        if (HAS_Y) {
            f32x4 y[4];
#pragma unroll
            for (int j = 0; j < 4; ++j) { const u32x2 yw = yc[j]; y[j] = (f32x4){bflo(yw.x), bfhi(yw.x), bflo(yw.y), bfhi(yw.y)}; }
            const float rs = 1.0f / sqrtf(wave_sum(pvc) * (1.0f / D) + 1e-6f);
#pragma unroll
            for (int j = 0; j < 4; ++j) { x[j] = x[j] + GG[j] * (y[j] * rs);
                if (XOUT_BF) { u32x2 w; w.x = cvt_pk_bf16(x[j][0], x[j][1]); w.y = cvt_pk_bf16(x[j][2], x[j][3]); __builtin_nontemporal_store(w, (u32x2*)((bf16_t*)xout_v + (size_t)row * D + 4 * lane + 256 * j)); }
                else __builtin_nontemporal_store(x[j], (f32x4*)((float*)xout_v + (size_t)row * D + 4 * lane + 256 * j)); }
        }
        if (NH >= 1) {
            float s = 0.f;
#pragma unroll
            for (int j = 0; j < 4; ++j) s += (x[j][0] * x[j][0] + x[j][1] * x[j][1]) + (x[j][2] * x[j][2] + x[j][3] * x[j][3]);
            const float rstd = 1.0f / sqrtf(wave_sum(s) * (1.0f / D) + 1e-6f);
            int hrow = row;
            if (PERMROWS) { const int t = row & 255; hrow = (row & ~255) + 128 * ((t >> 2) & 1) + 64 * (t >> 7) + 16 * (t & 3) + ((t >> 3) & 15); }
#pragma unroll
            for (int j = 0; j < 4; ++j) { const f32x4 h = (x[j] * rstd) * A1[j] + B1[j]; u32x2 w; w.x = cvt_pk_bf16(h[0], h[1]); w.y = cvt_pk_bf16(h[2], h[3]);
                *(u32x2*)(H1 + (size_t)hrow * D + 4 * lane + 256 * j) = w; }
            if (NH >= 2) {
#pragma unroll
                for (int j = 0; j < 4; ++j) { const f32x4 h = (x[j] * rstd) * A2[j] + B2[j]; u32x2 w; w.x = cvt_pk_bf16(h[0], h[1]); w.y = cvt_pk_bf16(h[2], h[3]);
                    *(u32x2*)(H2 + (size_t)row * D + 4 * lane + 256 * j) = w; }
            }
        }
    }
#undef TP_LOAD
}

__global__ void __launch_bounds__(512, 2) mk_fwd(Args a) {
    extern __shared__ __attribute__((aligned(16))) unsigned char lds_raw[];
    LAS unsigned char* lds = (LAS unsigned char*)lds_raw;
    cg::grid_group grid = cg::this_grid();
    const int tid = threadIdx.x, lane = tid & 63, wave = __builtin_amdgcn_readfirstlane(tid >> 6);
    const int G = gridDim.x, bx = blockIdx.x;
    const int vcu = (G % 8 == 0) ? (bx % 8) * (G / 8) + bx / 8 : bx;
    const int gw = vcu * 8 + wave, NGW = G * 8;
    unsigned char* ws = a.ws;
    if (tid < 16) ((LAS unsigned*)(lds + LDS_MISC))[tid] = 0u;
    __syncthreads();
    if (bx == 0) { for (int i = tid; i < (int)(BAR_ZERO_BYTES / 4); i += 512) ((unsigned*)(ws + WS_BAR))[i] = 0u; __threadfence(); }
    const float* x_in = (const float*)a.in[0];
    const float* c_in = (const float*)a.in[1];
    const int* pos_in = (const int*)a.in[2];
    const float* mod_mix_w = (const float*)a.in[3]; const float* mod_mix_b = (const float*)a.in[4];
    const float* mod_ffn_w = (const float*)a.in[5]; const float* mod_ffn_b = (const float*)a.in[6];
    const float* norm_pre_mix = (const float*)a.in[7]; const float* norm_post_mix = (const float*)a.in[8];
    const float* norm_pre_ffn = (const float*)a.in[9]; const float* norm_post_ffn = (const float*)a.in[10];
    const float* ffn_w_gate = (const float*)a.in[11]; const float* ffn_w_up = (const float*)a.in[12];
    const float* ffn_conv_w = (const float*)a.in[13]; const float* ffn_conv_b = (const float*)a.in[14];
    const float* ffn_w_down = (const float*)a.in[15];
    const float* a_w_qkv = (const float*)a.in[16]; const float* a_w_o = (const float*)a.in[17];
    const float* kv_norm = (const float*)a.in[18]; const float* kv_mod_w = (const float*)a.in[19]; const float* kv_mod_b = (const float*)a.in[20];
    const float* b_w_k = (const float*)a.in[21]; const float* b_w_v = (const float*)a.in[22]; const float* b_w_q = (const float*)a.in[23];
    const float* lq1 = (const float*)a.in[24]; const float* lk1 = (const float*)a.in[25]; const float* lq2 = (const float*)a.in[26]; const float* lk2 = (const float*)a.in[27];
    const float* b_subln = (const float*)a.in[28]; const float* b_w_o = (const float*)a.in[29];
    float* out = a.out;
    float* MODS = (float*)(ws + WS_MODS);
    float* ROPE = (float*)(ws + WS_ROPE);
    float* SSQ = (float*)(ws + WS_SSQ);
    float* LSE = (float*)(ws + WS_LSE);
    bf16_t* WQKV = (bf16_t*)(ws + WS_WQKV); bf16_t* WOA = (bf16_t*)(ws + WS_WOA);
    bf16_t* WKV = (bf16_t*)(ws + WS_WKV); bf16_t* WQ1 = (bf16_t*)(ws + WS_WQ1); bf16_t* WOB = (bf16_t*)(ws + WS_WOB);
    bf16_t* Hb = (bf16_t*)(ws + WS_H);
    unsigned char* R = ws + WS_R;
    bf16_t* X1 = (bf16_t*)out; bf16_t* X2 = (bf16_t*)out + (size_t)M * D; bf16_t* X3 = (bf16_t*)(R + 96 * MiB);

    STAMP(0);
    REP(6) { __syncthreads();
    if (PH(0) && bx < 224) {
        const float* W; const float* bias; int ldw, col0; float* mo;
        if (bx < 192) { const int mat = bx / 48, cb = bx % 48; const int l = mat >> 1; col0 = cb * 64; ldw = 3072;
            W = ((mat & 1) ? mod_ffn_w : mod_mix_w) + (size_t)l * D * 3072; bias = ((mat & 1) ? mod_ffn_b : mod_mix_b) + l * 3072; mo = MODS + (size_t)mat * 8 * 3072; }
        else { const int cb = bx - 192; col0 = cb * 64; ldw = 2048; W = kv_mod_w; bias = kv_mod_b; mo = MODS + (size_t)4 * 8 * 3072; }
        LAS float* cact = (LAS float*)lds;
        LAS float* red = (LAS float*)(lds + 32768);
        for (int i = tid; i < 8 * 1024; i += 512) { const int b = i >> 10, k = i & 1023; const float cv = c_in[b * 1024 + k]; cact[k * 8 + b] = cv / (1.0f + __expf(-cv)); }
        __syncthreads();
        float acc[8];
#pragma unroll
        for (int b = 0; b < 8; ++b) acc[b] = 0.f;
        const float* wp = W + (size_t)(wave * 128) * ldw + col0 + lane;
#pragma unroll 16
        for (int k = 0; k < 128; ++k) {
            const float w = __builtin_nontemporal_load(wp + (size_t)k * ldw);
            const f32x4 c0 = *(const LAS f32x4*)(cact + (wave * 128 + k) * 8), c1 = *(const LAS f32x4*)(cact + (wave * 128 + k) * 8 + 4);
            acc[0] += c0[0] * w; acc[1] += c0[1] * w; acc[2] += c0[2] * w; acc[3] += c0[3] * w;
            acc[4] += c1[0] * w; acc[5] += c1[1] * w; acc[6] += c1[2] * w; acc[7] += c1[3] * w;
        }
#pragma unroll
        for (int b = 0; b < 8; ++b) red[(wave * 8 + b) * 64 + lane] = acc[b];
        __syncthreads();
        { const int b = tid >> 6; float s = bias[col0 + lane];
#pragma unroll
          for (int w = 0; w < 8; ++w) s += red[(w * 8 + b) * 64 + lane];
          mo[b * 3072 + col0 + lane] = s; }
        __syncthreads();
    }
    if (PH(0)) {
        const float invf[8] = {1.0f, 0.1939227432012558f, 0.03760603070259094f, 0.007292664609849453f, 0.0014142135623842478f, 0.00027424818836152554f, 5.318296098266728e-05f, 1.0313386155758053e-05f};
        for (int i = bx * 512 + tid; i < M * 8; i += G * 512) {
            const int row = i >> 3, j = i & 7;
            float iv = invf[0];
#pragma unroll
            for (int q = 1; q < 8; ++q) iv = (j == q) ? invf[q] : iv;
            const float ang = (float)pos_in[row] * iv;
            double rev = (double)ang * 0.15915494309189535; rev -= __builtin_rint(rev);
            const float rf = (float)rev;
            ROPE[(size_t)i * 2] = __builtin_amdgcn_cosf(rf); ROPE[(size_t)i * 2 + 1] = __builtin_amdgcn_sinf(rf);
        }
    }
    if (PH(0)) {
        LAS float* scr = (LAS float*)(lds + wave * 16384);
        constexpr int I_QKV = 16 * 144, I_OA = 8 * 32, I_GU = 16 * 88, I_DN = 44 * 32, I_SQ = 16 * 32;
        constexpr int NITEMS = I_QKV + I_OA + 4 * I_GU + 2 * I_DN + 4 * I_SQ;
        for (int it = gw; it < NITEMS; it += NGW) {
            int r = it;
            if (r < I_QKV) { transpose_item(a_w_qkv, D, NQKV, WQKV, 0, 2, scr, r, lane); continue; } r -= I_QKV;
            if (r < I_OA) { transpose_item(a_w_o, 512, D, WOA, 0, 0, scr, r, lane); continue; } r -= I_OA;
            if (r < 4 * I_GU) { const int w = r / I_GU, l = w >> 1, up = w & 1; r -= w * I_GU;
                transpose_item((up ? ffn_w_up : ffn_w_gate) + (size_t)l * D * FF, D, FF, (bf16_t*)(ws + (l ? WS_WG1 : WS_WG0)), 0, up ? 4 : 3, scr, r, lane); continue; } r -= 4 * I_GU;
            if (r < 2 * I_DN) { const int l = r / I_DN; r -= l * I_DN;
                transpose_item(ffn_w_down + (size_t)l * FF * D, FF, D, (bf16_t*)(ws + (l ? WS_WD1 : WS_WD0)), 0, 0, scr, r, lane); continue; } r -= 2 * I_DN;
            if (r < I_SQ) { transpose_item(b_w_k, D, D, WKV, 0, 1, scr, r, lane); continue; } r -= I_SQ;
            if (r < I_SQ) { transpose_item(b_w_v, D, D, WKV, 1024, 0, scr, r, lane); continue; } r -= I_SQ;
            if (r < I_SQ) { transpose_item(b_w_q, D, D, WQ1, 0, 1, scr, r, lane); continue; } r -= I_SQ;
            transpose_item(b_w_o, D, D, WOB, 0, 0, scr, r, lane);
        }
    }
    if (rep_ > 0) { grid.sync(); } }
    grid.sync();
    const XcdBarrier xbar = xcd_barrier_post((unsigned*)(ws + WS_BAR), (volatile LAS unsigned*)(lds + LDS_MISC));

    REP(5) { if (PH(1)) thin_pass<false, 1>(gw, NGW, lane, x_in, nullptr, nullptr, nullptr, nullptr, nullptr,
                        norm_pre_mix, MODS + 0 * 8 * 3072 + 1024, MODS + 0 * 8 * 3072, Hb, nullptr, nullptr, nullptr, nullptr);
    GSYNC(); } STAMP(1);

    bf16_t* QKV0 = (bf16_t*)R;
    REP(1) { if (PH(2)) {
        pg8::Gemm g{Hb, WQKV, M, NQKV, D}; pg8::StaticOrder So; So.init(M, NQKV, G, bx);
        pg8::EpiRope<0> E{QKV0, NQKV, ROPE, 0};
        pg8::gemm_phase<pg8::EpiRope<0>, pg8::StaticOrder, true, true>(lds, g, So, E);
    }
    GSYNC(); } STAMP(2);

    bf16_t* OG = (bf16_t*)(R + 288 * MiB);
    REP(2) { if (PH(3)) for (int u = vcu; u < 3072; u += G) {
        const int bgh = u >> 4, qblk = u & 15; const int b = bgh / 24, g = (bgh % 24) >> 3, h = bgh & 7;
        const int dil = (g == 0) ? 1 : (g == 1 ? 4 : 16), L = S / dil;
        const int p0 = qblk * 256, rs = p0 / L, i0 = p0 % L;
        const size_t segbase = (size_t)b * S + (size_t)rs * L;
        const bf16_t* Qp = QKV0 + ((size_t)b * S + p0) * NQKV + g * 1536 + h * 64;
        const bf16_t* Kp = QKV0 + segbase * NQKV + g * 1536 + 512 + h * 64;
        const bf16_t* Vp = QKV0 + segbase * NQKV + g * 1536 + 1024 + h * 64;
        f32x16 o[2]; float mr, lr;
        attn_core<64, true>(lds, Qp, NQKV, Kp, NQKV, Vp, NQKV, i0, o, mr, lr);
        const int r32 = lane & 31, hi = lane >> 5;
        const int qi = i0 + wave * 32 + r32;
        const size_t row = (size_t)b * S + (size_t)qi * dil + rs;
        const float inv = 1.0f / lr;
        bf16_t* op = OG + ((size_t)g * M + row) * 512 + h * 64 + 8 * hi;
#pragma unroll
        for (int i = 0; i < 2; ++i)
#pragma unroll
            for (int k2 = 0; k2 < 2; ++k2) { u32x2 wa, wb; const int q4 = 2 * k2;
                wa.x = cvt_pk_bf16(o[i][4 * q4] * inv, o[i][4 * q4 + 1] * inv); wa.y = cvt_pk_bf16(o[i][4 * q4 + 2] * inv, o[i][4 * q4 + 3] * inv);
                wb.x = cvt_pk_bf16(o[i][4 * q4 + 4] * inv, o[i][4 * q4 + 5] * inv); wb.y = cvt_pk_bf16(o[i][4 * q4 + 6] * inv, o[i][4 * q4 + 7] * inv);
                *(u32x4*)(op + i * 32 + 16 * k2) = pair16(wa, wb); }
        if (hi == 0) LSE[((size_t)g * M + row) * 8 + h] = mr + __log2f(lr);
    }
    GSYNC(); } STAMP(3);

    bf16_t* MIX = Hb;
    if (PH(4)) {
        int lane_o = lane; asm volatile("" : "+v"(lane_o)); const int lane = lane_o;
        const int rpw = (M + NGW - 1) / NGW; const int r0 = gw * rpw; const int r1 = (r0 + rpw < M) ? (r0 + rpw) : M;
        for (int row = r0; row < r1; ++row) {
            const int h = lane >> 3;
            const float l0 = LSE[((size_t)0 * M + row) * 8 + h], l1 = LSE[((size_t)1 * M + row) * 8 + h], l2 = LSE[((size_t)2 * M + row) * 8 + h];
            const float mx = fmaxf(l0, fmaxf(l1, l2));
            float w0 = __builtin_amdgcn_exp2f(l0 - mx), w1 = __builtin_amdgcn_exp2f(l1 - mx), w2 = __builtin_amdgcn_exp2f(l2 - mx);
            const float ws_ = 1.0f / (w0 + w1 + w2); w0 *= ws_; w1 *= ws_; w2 *= ws_;
            const u32x4 a0 = __builtin_nontemporal_load((const u32x4*)(OG + ((size_t)0 * M + row) * 512 + 8 * lane)), a1 = __builtin_nontemporal_load((const u32x4*)(OG + ((size_t)1 * M + row) * 512 + 8 * lane)), a2 = __builtin_nontemporal_load((const u32x4*)(OG + ((size_t)2 * M + row) * 512 + 8 * lane));
            u32x4 w;
#pragma unroll
            for (int e = 0; e < 4; ++e) { const float lo = w0 * bflo(a0[e]) + w1 * bflo(a1[e]) + w2 * bflo(a2[e]), hh = w0 * bfhi(a0[e]) + w1 * bfhi(a1[e]) + w2 * bfhi(a2[e]); w[e] = cvt_pk_bf16(lo, hh); }
            *(u32x4*)(MIX + (size_t)row * 512 + 8 * lane) = w;
        }
    }
    GSYNC();

    bf16_t* Y = (bf16_t*)R;
    if (PH(5)) {
        pg8::Gemm g{MIX, WOA, M, D, 512}; pg8::StaticOrder So; So.init(M, D, G, bx);
        pg8::EpiY E{Y, D, SSQ};
        pg8::gemm_phase<pg8::EpiY, pg8::StaticOrder, true, true>(lds, g, So, E);
    }
    GSYNC();

    for (int l = 0; l < 2; ++l) {
        if (l == 1) {
            bf16_t* HK = (bf16_t*)(R + 128 * MiB);
            bf16_t* Kb = (bf16_t*)(R + 192 * MiB);
            bf16_t* Qb = (bf16_t*)R;
            if (PH(6)) {
                pg8::Gemm g{HK, WKV, M, 2048, D}; pg8::StaticOrder So; So.init(M, 2048, G, bx);
                pg8::EpiRope<1> E{Kb, D, ROPE, (size_t)M * D};
                pg8::gemm_phase<pg8::EpiRope<1>, pg8::StaticOrder, true, true>(lds, g, So, E);
            }
            if (PH(7)) {
                pg8::Gemm g{Hb, WQ1, M, D, D}; pg8::StaticOrder So; So.init(M, D, G, bx);
                pg8::EpiRope<2> E{Qb, D, ROPE, 0};
                pg8::gemm_phase<pg8::EpiRope<2>, pg8::StaticOrder, true, true>(lds, g, So, E);
            }
            GSYNC(); STAMP(7);
            bf16_t* Vb = Kb + (size_t)M * D;
            bf16_t* O1 = (bf16_t*)(R + 128 * MiB);
            bf16_t* O2 = (bf16_t*)(R + 64 * MiB);
            REP(3) { if (PH(8)) {
                int lane_o = lane; asm volatile("" : "+v"(lane_o)); const int lane = lane_o;
                const float lv1 = lq1[lane] * lk1[lane], lv2 = lq2[lane] * lk2[lane];
                const float lam = __expf(wave_sum(lv1)) - __expf(wave_sum(lv2)) + LAM_INIT;
                const int per = (1024 + G - 1) / G;
                for (int it = 0; it < per; ++it) {
                    int b, h, qb;
                    if (G == 256) {
                        const int xcd = vcu >> 5, jc = vcu & 31, bh = xcd * 8 + it * 2 + (jc >> 4); b = bh >> 3; h = bh & 7; qb = (it & 1) ? (15 - (jc & 15)) : (jc & 15);
                    } else {
                        const int slot = vcu * per + it; if (slot >= 1024) break;
                        const int combo = slot >> 4, j = slot & 15; qb = (j & 1) ? (15 - (j >> 1)) : (j >> 1); b = combo >> 3; h = combo & 7;
                    }
                    const int r32 = lane & 31, hi = lane >> 5;
                    const size_t row = (size_t)b * S + qb * 256 + wave * 32 + r32;
                    bf16_t* o1p = O1 + row * D + h * 128 + 4 * hi;
#pragma unroll 1
                    for (int cc = 0; cc < 2; ++cc) {
                        const int hc = 2 * h + cc;
                        const bf16_t* Qp = Qb + ((size_t)b * S + qb * 256) * D + hc * 64;
                        const bf16_t* Kp = Kb + ((size_t)b * S) * D + hc * 64;
                        const bf16_t* Vp = Vb + ((size_t)b * S) * D + h * 128;
                        f32x16 o[4]; float mr, lr;
                        attn_core<128, false>(lds, Qp, D, Kp, D, Vp, D, qb * 256, o, mr, lr);
                        const float inv = 1.0f / lr;
                        if (cc == 0) {
#pragma unroll
                            for (int i = 0; i < 4; ++i)
#pragma unroll
                                for (int q4 = 0; q4 < 4; ++q4) { u32x2 w; w.x = cvt_pk_bf16(o[i][4 * q4] * inv, o[i][4 * q4 + 1] * inv); w.y = cvt_pk_bf16(o[i][4 * q4 + 2] * inv, o[i][4 * q4 + 3] * inv); *(u32x2*)(o1p + i * 32 + 8 * q4) = w; }
                        } else {
                            float ss = 0.f;
#pragma unroll
                            for (int i = 0; i < 4; ++i)
#pragma unroll
                                for (int q4 = 0; q4 < 4; ++q4) { const u32x2 w = *(const u32x2*)(o1p + i * 32 + 8 * q4);
                                    const float v0 = bflo(w.x) - lam * (o[i][4 * q4] * inv), v1 = bfhi(w.x) - lam * (o[i][4 * q4 + 1] * inv), v2 = bflo(w.y) - lam * (o[i][4 * q4 + 2] * inv), v3 = bfhi(w.y) - lam * (o[i][4 * q4 + 3] * inv);
                                    o[i][4 * q4] = v0; o[i][4 * q4 + 1] = v1; o[i][4 * q4 + 2] = v2; o[i][4 * q4 + 3] = v3; ss += (v0 * v0 + v1 * v1) + (v2 * v2 + v3 * v3); }
                            ss += __shfl_xor(ss, 32);
                            const float rstd = (1.0f - LAM_INIT) / sqrtf(ss * (1.0f / 128.0f) + 1e-5f);
                            bf16_t* op = Hb + row * D + h * 128 + 8 * hi;
#pragma unroll
                            for (int i = 0; i < 4; ++i)
#pragma unroll
                                for (int k2 = 0; k2 < 2; ++k2) { const int q4 = 2 * k2; const f32x4 sga = ld4(b_subln + i * 32 + 8 * q4 + 4 * hi), sgb = ld4(b_subln + i * 32 + 8 * q4 + 8 + 4 * hi);
                                    u32x2 wa, wb;
                                    wa.x = cvt_pk_bf16(o[i][4 * q4] * rstd * sga[0], o[i][4 * q4 + 1] * rstd * sga[1]); wa.y = cvt_pk_bf16(o[i][4 * q4 + 2] * rstd * sga[2], o[i][4 * q4 + 3] * rstd * sga[3]);
                                    wb.x = cvt_pk_bf16(o[i][4 * q4 + 4] * rstd * sgb[0], o[i][4 * q4 + 5] * rstd * sgb[1]); wb.y = cvt_pk_bf16(o[i][4 * q4 + 6] * rstd * sgb[2], o[i][4 * q4 + 7] * rstd * sgb[3]);
                                    *(u32x4*)(op + i * 32 + 16 * k2) = pair16(wa, wb); }
                        }
                    }
                }
            }
            GSYNC(); } STAMP(8);
            if (PH(10)) {
                pg8::Gemm g{Hb, WOB, M, D, D}; pg8::StaticOrder So; So.init(M, D, G, bx);
                pg8::EpiY E{Y, D, SSQ};
                pg8::gemm_phase<pg8::EpiY, pg8::StaticOrder, true, true>(lds, g, So, E);
            }
            GSYNC();
        }
        if (PH(11)) {
            const float* mm = MODS + (size_t)(2 * l) * 8 * 3072;
            const float* mf = MODS + (size_t)(2 * l + 1) * 8 * 3072;
            if (l == 0) thin_pass<true, 1, true, false, true>(gw, NGW, lane, x_in, X1, Y, SSQ, norm_post_mix, mm + 2048,
                               norm_pre_ffn, mf + 1024, mf, Hb, nullptr, nullptr, nullptr, nullptr);
            else thin_pass<true, 1, true, true, true>(gw, NGW, lane, X2, X3, Y, SSQ, norm_post_mix + D, mm + 2048,
                               norm_pre_ffn + D, mf + 1024, mf, Hb, nullptr, nullptr, nullptr, nullptr);
        }
        GSYNC(); STAMP(l == 0 ? 4 : 9);
        bf16_t* Fb = (bf16_t*)(R + 176 * MiB);
        float* BND = (float*)(R + 64 * MiB);
        float* HALO = (float*)(R + 80 * MiB);
        REP(4) { REP(7) { if (PH(12)) {
            pg8::Gemm g{Hb, (const bf16_t*)(ws + (l ? WS_WG1 : WS_WG0)), M, 2 * FF, D}; pg8::StaticOrder So; So.init(M, 2 * FF, G, bx);
            pg8::EpiGateUp E{Fb, ffn_conv_w + (size_t)l * 3 * FF, ffn_conv_b + (size_t)l * FF, FF, BND, HALO};
            pg8::gemm_phase<pg8::EpiGateUp, pg8::StaticOrder, true, true>(lds, g, So, E);
        }
        GSYNC(); }
        if (PH(13)) {
            const float* cw = ffn_conv_w + (size_t)l * 3 * FF; const float* cb = ffn_conv_b + (size_t)l * FF;
            int tid_o = tid; asm volatile("" : "+v"(tid_o));
            for (int i = bx * 512 + tid_o; i < 512 * (FF / 4); i += G * 512) {
                const int c4 = (i % (FF / 4)) * 4, kj = i / (FF / 4), k = kj >> 1, j = kj & 1;
                const bool first = ((k & 31) == 0);
                const f32x4 z = (f32x4){0.f, 0.f, 0.f, 0.f};
                const f32x4 h6 = first ? z : *(const f32x4*)(HALO + (size_t)((k - 1) * 2 + 0) * FF + c4), h7 = first ? z : *(const f32x4*)(HALO + (size_t)((k - 1) * 2 + 1) * FF + c4);
                const f32x4 a0 = *(const f32x4*)(BND + ((size_t)(k * 2 + 0) * 2 + 0) * FF + c4), a1 = *(const f32x4*)(BND + ((size_t)(k * 2 + 1) * 2 + 0) * FF + c4);
                const f32x4 uu = *(const f32x4*)(BND + ((size_t)(k * 2 + j) * 2 + 1) * FF + c4);
                const f32x4 am2 = j ? h7 : h6, am1 = j ? a0 : h7, aj = j ? a1 : a0;
                const f32x4 cv = ld4(cb + c4) + ld4(cw + c4) * am2 + ld4(cw + FF + c4) * am1 + ld4(cw + 2 * FF + c4) * aj;
                u32x2 w; w.x = cvt_pk_bf16(pg8::gelu_tanh_f(cv[0]) * uu[0], pg8::gelu_tanh_f(cv[1]) * uu[1]); w.y = cvt_pk_bf16(pg8::gelu_tanh_f(cv[2]) * uu[2], pg8::gelu_tanh_f(cv[3]) * uu[3]);
                *(u32x2*)(Fb + (size_t)(k * 128 + j) * FF + c4) = w;
            }
        }
        GSYNC(); if (l == 0) STAMP(5);
        REP(8) { if (PH(14)) {
            pg8::Gemm g{Fb, (const bf16_t*)(ws + (l ? WS_WD1 : WS_WD0)), M, D, FF}; pg8::StaticOrder So; So.init(M, D, G, bx);
            pg8::EpiY E{Y, D, SSQ};
            pg8::gemm_phase<pg8::EpiY, pg8::StaticOrder, true, true>(lds, g, So, E);
        }
        GSYNC(); } } if (l == 0) STAMP(6);
        if (PH(15)) {
            const float* mf = MODS + (size_t)(2 * l + 1) * 8 * 3072;
            if (l == 0) {
                const float* mm1 = MODS + (size_t)2 * 8 * 3072; const float* mkv = MODS + (size_t)4 * 8 * 3072;
                thin_pass<true, 2, false, true, true>(gw, NGW, lane, X1, X2, Y, SSQ, norm_post_ffn, mf + 2048,
                                   norm_pre_mix + D, mm1 + 1024, mm1, Hb, kv_norm, mkv + 1024, mkv, (bf16_t*)(R + 128 * MiB));
                GSYNC();
            } else {
                thin_pass<true, 0, false, true, false>(gw, NGW, lane, X3, out, Y, SSQ, norm_post_ffn + D, mf + 2048,
                                   nullptr, nullptr, nullptr, nullptr, nullptr, nullptr, nullptr, nullptr);
            }
        }
    }
#ifdef PROBE_R
    GSYNC(); STAMP(10); GSYNC();
    {
        const volatile unsigned long long* ts = (const volatile unsigned long long*)(a.ws + 520192);
        const int ga = 2 * PROBE_R + 1, gb = 2 * PROBE_R + 2;
        const float tA = (float)(ts[ga] - ts[ga - 1]) * 0.01f, tB = (float)(ts[gb] - ts[gb - 1]) * 0.01f;
        if (bx == 0 && tid == 0) out[0] += tA;
        for (int i = bx * 512 + tid; i < (1 << 20); i += G * 512) out[1024 + i] += tB * (1.0f / 16.0f);
    }
#endif
}

extern "C" void kernel_launch(void* const* d_in, const int* in_sizes, int n_in, void* d_out, int out_size, void* d_ws, size_t ws_size, hipStream_t stream) {
    static int grid = 0;
    if (grid == 0) {
        if (n_in != 30 || out_size != M * D || ws_size < WS_END) { fprintf(stderr, "kernel_launch: unexpected shapes (n_in %d out %d ws %zu)\n", n_in, out_size, ws_size); grid = -1; return; }
        int dev = 0, cus = 0, per_cu = 0;
        (void)hipGetDevice(&dev);
        (void)hipDeviceGetAttribute(&cus, hipDeviceAttributeMultiprocessorCount, dev);
        (void)hipFuncSetAttribute((const void*)mk_fwd, hipFuncAttributeMaxDynamicSharedMemorySize, LDS_BYTES);
        (void)hipOccupancyMaxActiveBlocksPerMultiprocessor(&per_cu, (const void*)mk_fwd, 512, LDS_BYTES);
        if (per_cu < 1) per_cu = 1;
        grid = cus * per_cu;
    }
    if (grid < 0) return;
    Args a{};
    for (int i = 0; i < 30; ++i) a.in[i] = d_in[i];
    a.out = (float*)d_out; a.ws = (unsigned char*)d_ws;
    void* args[] = {&a};
    hipError_t e = hipLaunchCooperativeKernel((const void*)mk_fwd, dim3(grid), dim3(512), args, LDS_BYTES, stream);
    if (e != hipSuccess) fprintf(stderr, "cooperative launch failed: %s (grid %d)\n", hipGetErrorString(e), grid);
}
```

```cpp
#include <hip/hip_runtime.h>
#include <hip/hip_cooperative_groups.h>
#include <cstdio>
#include <cstdint>
#include <type_traits>
namespace cg = cooperative_groups;
constexpr float QSCALE = 0.125f * 1.4426950408889634f;
namespace pg8 {
#define PG8_LAS __attribute__((address_space(3)))
typedef unsigned short bf16_t;
typedef short bf16x8 __attribute__((ext_vector_type(8)));
typedef float f32x4 __attribute__((ext_vector_type(4)));
typedef unsigned u32x4 __attribute__((ext_vector_type(4)));
constexpr int BM = 256, BK = 64, HALF = 128, HTB = HALF * BK * 2  , STAGE_BYTES = 8 * HTB, NXCD = 8, WGM = 8;

__host__ __device__ __forceinline__ int lds_byte(int r, int c) { const int st = (r >> 4) * 2 + (c >> 5), rr = r & 15, cc = c & 31, ob = rr * 64 + cc * 2; return st * 1024 + (ob ^ (((ob >> 9) & 1) << 5)); }
__host__ __device__ __forceinline__ void stage_rc(int b, int& R, int& C) { const int st = b / 1024, sb = b % 1024, swz = sb ^ (((sb >> 9) & 1) << 5); R = (st >> 1) * 16 + swz / 64; C = (st & 1) * 32 + (swz % 64) / 2; }
__host__ __device__ __forceinline__ int perm32(int rho) { const int n = rho >> 4, i = rho & 15; return 8 * (i >> 2) + 4 * n + (i & 3); }

struct Unit { int pm, pn; };
struct Gemm { const bf16_t* A; const bf16_t* Bt; int M, N, K; };

struct StaticOrder {
    int nM, nN, nwg, G, c;
    __host__ __device__ void init(int M, int N, int G_, int c_) { nM = M / BM; nN = N / BM; nwg = nM * nN; G = G_; c = c_; }
    __host__ __device__ bool next(int i, Unit& u) const {
        const long L = (long)i * G + c; if (L >= nwg) return false;
        int wgid = (int)L; { const int q = nwg / NXCD, r = nwg % NXCD, xcd = wgid % NXCD, off = wgid / NXCD; wgid = (xcd < r ? xcd * (q + 1) : r * (q + 1) + (xcd - r) * q) + off; }
        const int nig = WGM * nN, gid = wgid / nig, fm = gid * WGM, gsz = (nM - fm) < WGM ? (nM - fm) : WGM;
        u.pm = fm + ((wgid % nig) % gsz); u.pn = (wgid % nig) / gsz; return true;
    }
    __device__ __forceinline__ void a_ready(const Unit&) const {}
    __device__ __forceinline__ void done(const Unit&) const {}
};
__device__ __forceinline__ unsigned cvt_pk_bf16(float lo, float hi) { unsigned r; asm volatile("v_cvt_pk_bf16_f32 %0, %1, %2" : "=v"(r) : "v"(lo), "v"(hi)); return r; }
typedef float f32x2 __attribute__((ext_vector_type(2)));
typedef unsigned u32x2 __attribute__((ext_vector_type(2)));
__device__ __forceinline__ void st16_wt(void* p, u32x4 v) { asm volatile("global_store_dwordx4 %0, %1, off sc1\n\ts_nop 2" : : "v"(p), "v"(v) : "memory"); }
struct EpiBf16P {
    static constexpr bool PERM = true, AFTER_DRAIN = false;
    bf16_t* O; int ldc;
    __device__ __forceinline__ void operator()(const f32x4 (&acc)[2][2][4][2], const Unit& u, int wr, int wc, int fr, int fq) const {
        const int row0 = u.pm * BM + wr * 64 + fr, col0 = u.pn * BM + wc * 32 + 8 * fq;
#pragma unroll
        for (int ai = 0; ai < 2; ++ai)
#pragma unroll
            for (int m = 0; m < 4; ++m) { bf16_t* rowp = O + (size_t)(row0 + ai * HALF + m * 16) * ldc + col0;
#pragma unroll
                for (int bj = 0; bj < 2; ++bj) { const f32x4 v0 = acc[ai][bj][m][0], v1 = acc[ai][bj][m][1];
                    u32x4 w; w.x = cvt_pk_bf16(v0[0], v0[1]); w.y = cvt_pk_bf16(v0[2], v0[3]); w.z = cvt_pk_bf16(v1[0], v1[1]); w.w = cvt_pk_bf16(v1[2], v1[3]);
                    *(u32x4*)(rowp + bj * HALF) = w; } }
    }
};
template <int MODE> struct EpiRope {
    static constexpr bool PERM = true, AFTER_DRAIN = false;
    bf16_t* O; int ldc; const float* rope; size_t split_stride;
    __device__ __forceinline__ void operator()(const f32x4 (&acc)[2][2][4][2], const Unit& u, int wr, int wc, int fr, int fq) const {
        const int colt = u.pn * BM;
        bool rot = true; float sc = 1.f; int dsh = 0; bf16_t* base = O; int ct = colt;
        if (MODE == 0) { const int g = colt / 1536, t = (colt % 1536) / 512; rot = t < 2; sc = (t == 0) ? QSCALE : 1.f; dsh = 2 * g; }
        else if (MODE == 1) { rot = colt < 1024; if (!rot) { base += split_stride; ct -= 1024; } }
        else { sc = QSCALE; }
        const int col0 = ct + wc * 32 + 8 * fq;
        const bool dorot = rot && ((wc & 1) == 0) && (fq < 2);
#pragma unroll
        for (int ai = 0; ai < 2; ++ai)
#pragma unroll
            for (int m = 0; m < 4; ++m) {
                const int row = u.pm * BM + ai * HALF + wr * 64 + m * 16 + fr;
                int orow = row;
                if (MODE == 0 && dsh > 0) { const int b = row >> 12, s = row & 4095; orow = (b << 12) + ((s & ((1 << dsh) - 1)) << (12 - dsh)) + (s >> dsh); }
                f32x4 cs0 = (f32x4){1.f, 0.f, 1.f, 0.f}, cs1 = (f32x4){1.f, 0.f, 1.f, 0.f};
                if (dorot) { const f32x4* rp = (const f32x4*)(rope + (size_t)row * 16 + fq * 8); cs0 = rp[0]; cs1 = rp[1]; }
                bf16_t* rowp = base + (size_t)orow * ldc + col0;
#pragma unroll
                for (int bj = 0; bj < 2; ++bj) { f32x4 v0 = acc[ai][bj][m][0], v1 = acc[ai][bj][m][1];
                    if (dorot) {
                        const f32x4 a = v0, b = v1;
                        v0[0] = a[0] * cs0[0] - a[1] * cs0[1]; v0[1] = a[1] * cs0[0] + a[0] * cs0[1];
                        v0[2] = a[2] * cs0[2] - a[3] * cs0[3]; v0[3] = a[3] * cs0[2] + a[2] * cs0[3];
                        v1[0] = b[0] * cs1[0] - b[1] * cs1[1]; v1[1] = b[1] * cs1[0] + b[0] * cs1[1];
                        v1[2] = b[2] * cs1[2] - b[3] * cs1[3]; v1[3] = b[3] * cs1[2] + b[2] * cs1[3];
                    }
                    v0 = v0 * sc; v1 = v1 * sc;
                    u32x4 w; w.x = cvt_pk_bf16(v0[0], v0[1]); w.y = cvt_pk_bf16(v0[2], v0[3]); w.z = cvt_pk_bf16(v1[0], v1[1]); w.w = cvt_pk_bf16(v1[2], v1[3]);
                    if (MODE == 0) __builtin_nontemporal_store(w, (u32x4*)(rowp + bj * HALF)); else st16_wt(rowp + bj * HALF, w); }
            }
    }
};
struct EpiY {
    static constexpr bool PERM = true, AFTER_DRAIN = false;
    bf16_t* Y; int ldc; float* ssq;
    __device__ __forceinline__ void operator()(const f32x4 (&acc)[2][2][4][2], const Unit& u, int wr, int wc, int fr, int fq) const {
        const int col0 = u.pn * BM + wc * 32 + 8 * fq;
#pragma unroll
        for (int ai = 0; ai < 2; ++ai)
#pragma unroll
            for (int m = 0; m < 4; ++m) {
                const int row = u.pm * BM + ai * HALF + wr * 64 + m * 16 + fr;
                bf16_t* rowp = Y + (size_t)row * ldc + col0; float s = 0.f;
#pragma unroll
                for (int bj = 0; bj < 2; ++bj) { const f32x4 v0 = acc[ai][bj][m][0], v1 = acc[ai][bj][m][1];
                    s += ((v0[0] * v0[0] + v0[1] * v0[1]) + (v0[2] * v0[2] + v0[3] * v0[3])) + ((v1[0] * v1[0] + v1[1] * v1[1]) + (v1[2] * v1[2] + v1[3] * v1[3]));
                    u32x4 w; w.x = cvt_pk_bf16(v0[0], v0[1]); w.y = cvt_pk_bf16(v0[2], v0[3]); w.z = cvt_pk_bf16(v1[0], v1[1]); w.w = cvt_pk_bf16(v1[2], v1[3]);
                    st16_wt(rowp + bj * HALF, w); }
                s += __shfl_xor(s, 16); s += __shfl_xor(s, 32);
                if (fq == 0) ssq[(size_t)row * 16 + u.pn * 4 + wc] = s;
            }
    }
};
struct EpiUpConv {
    static constexpr bool PERM = true, AFTER_DRAIN = false;
    const bf16_t* A; bf16_t* Fo; const float* cw; const float* cb; int ff;
    __device__ __forceinline__ void operator()(const f32x4 (&acc)[2][2][4][2], const Unit& u, int wr, int wc, int fr, int fq) const {
        const int row0 = u.pm * BM + wr * 64 + fr;
#pragma unroll
        for (int bj = 0; bj < 2; ++bj) {
            const int col = u.pn * BM + bj * HALF + wc * 32 + 8 * fq;
            float w0[8], w1[8], w2[8], bb[8];
#pragma unroll
            for (int h = 0; h < 2; ++h) { const f32x4 t0 = *(const f32x4*)(cw + col + 4 * h), t1 = *(const f32x4*)(cw + ff + col + 4 * h), t2 = *(const f32x4*)(cw + 2 * ff + col + 4 * h), t3 = *(const f32x4*)(cb + col + 4 * h);
#pragma unroll
                for (int e = 0; e < 4; ++e) { w0[4 * h + e] = t0[e]; w1[4 * h + e] = t1[e]; w2[4 * h + e] = t2[e]; bb[4 * h + e] = t3[e]; } }
#pragma unroll
            for (int ai = 0; ai < 2; ++ai)
#pragma unroll
                for (int m = 0; m < 4; ++m) {
                    const int row = row0 + ai * HALF + m * 16; const int s = row & 4095;
                    const bf16_t* ap = A + (size_t)row * ff + col;
                    const u32x4 z = (u32x4){0u, 0u, 0u, 0u};
                    const u32x4 a2 = *(const u32x4*)ap;
                    const u32x4 a1 = (s >= 1) ? *(const u32x4*)(ap - ff) : z;
                    const u32x4 a0 = (s >= 2) ? *(const u32x4*)(ap - 2 * ff) : z;
                    float f[8];
#pragma unroll
                    for (int e = 0; e < 8; ++e) {
                        const unsigned x0 = a0[e >> 1], x1 = a1[e >> 1], x2 = a2[e >> 1];
                        const float f0 = __uint_as_float((e & 1) ? (x0 & 0xffff0000u) : (x0 << 16));
                        const float f1 = __uint_as_float((e & 1) ? (x1 & 0xffff0000u) : (x1 << 16));
                        const float f2 = __uint_as_float((e & 1) ? (x2 & 0xffff0000u) : (x2 << 16));
                        const float cv = bb[e] + w0[e] * f0 + w1[e] * f1 + w2[e] * f2;
                        const float zz = 1.5957691216057308f * (cv + 0.044715f * cv * cv * cv);
                        const float ex = __builtin_amdgcn_exp2f(-1.4426950408889634f * zz);
                        const float gl = cv * __builtin_amdgcn_rcpf(1.0f + ex);
                        f[e] = gl * acc[ai][bj][m][e >> 2][e & 3];
                    }
                    u32x4 w; w.x = cvt_pk_bf16(f[0], f[1]); w.y = cvt_pk_bf16(f[2], f[3]); w.z = cvt_pk_bf16(f[4], f[5]); w.w = cvt_pk_bf16(f[6], f[7]);
                    *(u32x4*)(Fo + (size_t)row * ff + col) = w;
                }
        }
    }
};

__device__ __forceinline__ float dpp_shr1(float v) { return __int_as_float(__builtin_amdgcn_update_dpp(0, __float_as_int(v), 0x111, 0xf, 0xf, true)); }
__device__ __forceinline__ float gelu_tanh_f(float cv) {
    const float zz = 1.5957691216057308f * (cv + 0.044715f * cv * cv * cv);
    const float ex = __builtin_amdgcn_exp2f(-1.4426950408889634f * zz);
    return cv * __builtin_amdgcn_rcpf(1.0f + ex);
}
__device__ __forceinline__ f32x4 gelu_mul4(f32x4 x, f32x4 u) {
    const f32x4 t = (x * x) * (-0.10294324f) + (-2.3022082f);
    const f32x4 z = x * t;
    f32x4 e; e[0] = __builtin_amdgcn_exp2f(z[0]); e[1] = __builtin_amdgcn_exp2f(z[1]); e[2] = __builtin_amdgcn_exp2f(z[2]); e[3] = __builtin_amdgcn_exp2f(z[3]);
    const f32x4 d = e + 1.0f;
    f32x4 r; r[0] = __builtin_amdgcn_rcpf(d[0]); r[1] = __builtin_amdgcn_rcpf(d[1]); r[2] = __builtin_amdgcn_rcpf(d[2]); r[3] = __builtin_amdgcn_rcpf(d[3]);
    return (x * u) * r;
}
struct EpiGateUp {
    static constexpr bool PERM = true, AFTER_DRAIN = false;
    bf16_t* Fo; const float* cw; const float* cb; int ff; float* bnd; float* halo;
    __device__ __forceinline__ void operator()(const f32x4 (&acc)[2][2][4][2], const Unit& u, int wr, int wc, int fr, int fq) const {
        const int cbase = u.pn * HALF + wc * 32 + 8 * fq;
        const int chunk = 2 * u.pm + wr;
        const int T0 = chunk * 128 + 8 * fr;
        unsigned fo[8][4];
#pragma unroll
        for (int n = 0; n < 2; ++n) {
            const f32x4 w0 = *(const f32x4*)(cw + cbase + 4 * n), w1 = *(const f32x4*)(cw + ff + cbase + 4 * n), w2 = *(const f32x4*)(cw + 2 * ff + cbase + 4 * n), bb = *(const f32x4*)(cb + cbase + 4 * n);
            f32x4 am2, am1;
#pragma unroll
            for (int e = 0; e < 4; ++e) { am2[e] = dpp_shr1(acc[1][0][2][n][e]); am1[e] = dpp_shr1(acc[1][0][3][n][e]); }
#pragma unroll
            for (int j = 0; j < 8; ++j) {
                const f32x4 aj = acc[j >> 2][0][j & 3][n], uj = acc[j >> 2][1][j & 3][n];
                const f32x4 cv = bb + w0 * am2 + w1 * am1 + w2 * aj;
                const f32x4 f = gelu_mul4(cv, uj);
                fo[j][2 * n] = cvt_pk_bf16(f[0], f[1]); fo[j][2 * n + 1] = cvt_pk_bf16(f[2], f[3]);
                am2 = am1; am1 = aj;
            }
            if (fr == 0) {
#pragma unroll
                for (int j = 0; j < 2; ++j) { *(f32x4*)(bnd + ((size_t)(chunk * 2 + j) * 2 + 0) * ff + cbase + 4 * n) = acc[0][0][j][n]; *(f32x4*)(bnd + ((size_t)(chunk * 2 + j) * 2 + 1) * ff + cbase + 4 * n) = acc[0][1][j][n]; }
            }
            if (fr == 15) {
#pragma unroll
                for (int j = 0; j < 2; ++j) *(f32x4*)(halo + (size_t)(chunk * 2 + j) * ff + cbase + 4 * n) = acc[1][0][2 + j][n];
            }
        }
#pragma unroll
        for (int j = 0; j < 8; ++j) {
            if (!(fr == 0 && j < 2)) { u32x4 w; w.x = fo[j][0]; w.y = fo[j][1]; w.z = fo[j][2]; w.w = fo[j][3]; st16_wt(Fo + (size_t)(T0 + j) * ff + cbase, w); }
        }
    }
};
template <class Epi, class Sched, bool ALIGN_EPI = false, bool SP2 = false>
__device__ __forceinline__ void gemm_phase(PG8_LAS unsigned char* lds, const Gemm g, const Sched& S, const Epi& E) {
    int tid_l = threadIdx.x; asm volatile("" : "+v"(tid_l));
    const int tid = tid_l, wid = __builtin_amdgcn_readfirstlane(tid >> 6), lane = tid & 63, wr = wid >> 2, wc = wid & 3, fr = lane & 15, fq = lane >> 4;
    const int K = g.K, nt = K / BK;
    unsigned voffA[2], voffB[2];
#pragma unroll
    for (int i = 0; i < 2; ++i) { int R, C; stage_rc(tid * 16 + i * 8192, R, C); const int Rb = Epi::PERM ? ((R & ~31) + perm32(R & 31)) : R;
        voffA[i] = (unsigned)(R * K + C) * 2u; voffB[i] = (unsigned)(Rb * K + C) * 2u; }
    const size_t kstep = (size_t)(BK * 2);
    const size_t hstep = (size_t)HALF * K * 2;
    const size_t tstep = 2 * hstep;
    const unsigned ldsw = (unsigned)wid * 1024u;
    const int aoff = lds_byte(wr * 64 + fr, fq * 8), boff = lds_byte(wc * 32 + fr, fq * 8);
#define PG8_SA(b, h) (((b) * 2 + (h)) * HTB)
#define PG8_SB(b, h) ((4 + (b) * 2 + (h)) * HTB)
#define PG8_STAGE(bufoff, gbase, voff) do { _Pragma("unroll") for (int _i = 0; _i < 2; ++_i) \
        __builtin_amdgcn_global_load_lds((const unsigned*)((const char*)(gbase) + (voff)[_i]), (PG8_LAS unsigned*)(lds + (bufoff) + ldsw + _i * 8192), 16, 0, 0); } while (0)
#define PG8_LDA(dst, b, h) do { _Pragma("unroll") for (int m = 0; m < 4; ++m) _Pragma("unroll") for (int k = 0; k < 2; ++k) dst[m][k] = *(const PG8_LAS bf16x8*)(lds + PG8_SA(b, h) + aoff + m * 2048 + k * 1024); } while (0)
#define PG8_LDB(dst, b, h) do { _Pragma("unroll") for (int n = 0; n < 2; ++n) _Pragma("unroll") for (int k = 0; k < 2; ++k) dst[n][k] = *(const PG8_LAS bf16x8*)(lds + PG8_SB(b, h) + boff + n * 2048 + k * 1024); } while (0)
#define PG8_MMA(ai, bj, At, Bt) do { __builtin_amdgcn_s_setprio(1); _Pragma("unroll") for (int m = 0; m < 4; ++m) _Pragma("unroll") for (int n = 0; n < 2; ++n) _Pragma("unroll") for (int k = 0; k < 2; ++k) \
        acc[ai][bj][m][n] = __builtin_amdgcn_mfma_f32_16x16x32_bf16(Bt[n][k], At[m][k], acc[ai][bj][m][n], 0, 0, 0); __builtin_amdgcn_s_setprio(0); } while (0)
#define PG8_WAIT_V(n) asm volatile("s_waitcnt vmcnt(" #n ")" ::: "memory")
#define PG8_WAIT_L(n) asm volatile("s_waitcnt lgkmcnt(" #n ")" ::: "memory")
#define PG8_BAR __builtin_amdgcn_s_barrier()
#define PG8_SCHED __builtin_amdgcn_sched_barrier(0)
    Unit cur, nxt; int ui = 0;
    if (!S.next(0, cur)) return;
    f32x4 acc[2][2][4][2];
#pragma unroll
    for (int a = 0; a < 2; ++a)
#pragma unroll
        for (int b = 0; b < 2; ++b)
#pragma unroll
            for (int m = 0; m < 4; ++m)
#pragma unroll
                for (int n = 0; n < 2; ++n) acc[a][b][m][n] = (f32x4){0.f, 0.f, 0.f, 0.f};
    bf16x8 At[4][2], B0[2][2], B1[2][2];
    const char* cA = (const char*)g.A + (size_t)cur.pm * tstep; const char* cB = (const char*)g.Bt + (size_t)cur.pn * tstep;
    S.a_ready(cur);
    if constexpr (SP2) {
        PG8_STAGE(PG8_SB(0, 0), cB, voffB); PG8_STAGE(PG8_SB(0, 1), cB + hstep, voffB); PG8_STAGE(PG8_SA(0, 0), cA, voffA); PG8_STAGE(PG8_SA(0, 1), cA + hstep, voffA);
        if (wr == 1) PG8_BAR;
        PG8_WAIT_V(2); PG8_BAR;
        PG8_STAGE(PG8_SB(1, 0), cB + kstep, voffB); PG8_STAGE(PG8_SA(1, 0), cA + kstep, voffA); PG8_STAGE(PG8_SB(1, 1), cB + hstep + kstep, voffB);
        PG8_WAIT_V(6); PG8_BAR;
    } else {
        PG8_STAGE(PG8_SB(0, 0), cB, voffB); PG8_STAGE(PG8_SA(0, 0), cA, voffA); PG8_STAGE(PG8_SB(0, 1), cB + hstep, voffB); PG8_STAGE(PG8_SA(0, 1), cA + hstep, voffA);
        if (wr == 1) PG8_BAR;
        PG8_WAIT_V(4); PG8_BAR;
        PG8_STAGE(PG8_SB(1, 0), cB + kstep, voffB); PG8_STAGE(PG8_SA(1, 0), cA + kstep, voffA); PG8_STAGE(PG8_SB(1, 1), cB + hstep + kstep, voffB);
        PG8_WAIT_V(6); PG8_BAR;
    }
    for (;;) {
        const bool has_next = S.next(ui + 1, nxt);
        const char* nA = has_next ? (const char*)g.A + (size_t)nxt.pm * tstep : cA; const char* nB = has_next ? (const char*)g.Bt + (size_t)nxt.pn * tstep : cB;
        for (int t = 0; t < nt; t += 2) {
            const bool last = (t == nt - 2);
            const char* a1 = cA + (size_t)(t + 1) * kstep;
            const char* a2 = last ? nA : cA + (size_t)(t + 2) * kstep; const char* b2 = last ? nB : cB + (size_t)(t + 2) * kstep;
            const char* a3 = a2 + kstep; const char* b3 = b2 + kstep;
            if (last && has_next) S.a_ready(nxt);
            if constexpr (SP2) {
            PG8_LDB(B0, 0, 0); PG8_LDB(B1, 0, 1); PG8_SCHED; PG8_LDA(At, 0, 0); PG8_STAGE(PG8_SA(1, 1), a1 + hstep, voffA);
            PG8_WAIT_V(8); PG8_WAIT_L(0); PG8_BAR; PG8_MMA(0, 0, At, B0); PG8_MMA(0, 1, At, B1); PG8_BAR; PG8_SCHED;
            PG8_LDA(At, 0, 1); PG8_STAGE(PG8_SB(0, 0), b2, voffB); PG8_STAGE(PG8_SB(0, 1), b2 + hstep, voffB); PG8_STAGE(PG8_SA(0, 0), a2, voffA);
            PG8_WAIT_V(8); PG8_WAIT_L(0); PG8_BAR; PG8_MMA(1, 0, At, B0); PG8_MMA(1, 1, At, B1); PG8_BAR; PG8_SCHED;
            PG8_LDB(B0, 1, 0); PG8_LDB(B1, 1, 1); PG8_SCHED; PG8_LDA(At, 1, 0); PG8_STAGE(PG8_SA(0, 1), a2 + hstep, voffA);
            PG8_WAIT_V(8); PG8_WAIT_L(0); PG8_BAR; PG8_MMA(0, 0, At, B0); PG8_MMA(0, 1, At, B1); PG8_BAR; PG8_SCHED;
            PG8_LDA(At, 1, 1); PG8_STAGE(PG8_SB(1, 0), b3, voffB); PG8_STAGE(PG8_SB(1, 1), b3 + hstep, voffB); PG8_STAGE(PG8_SA(1, 0), a3, voffA);
            PG8_WAIT_V(8); PG8_WAIT_L(0); PG8_BAR; PG8_MMA(1, 0, At, B0); PG8_MMA(1, 1, At, B1); PG8_BAR; PG8_SCHED;
            } else {
            PG8_LDB(B0, 0, 0); PG8_SCHED; PG8_LDA(At, 0, 0); PG8_STAGE(PG8_SA(1, 1), a1 + hstep, voffA);
            PG8_WAIT_L(8); PG8_BAR; PG8_WAIT_L(0); PG8_MMA(0, 0, At, B0); PG8_BAR; PG8_SCHED;
            PG8_LDB(B1, 0, 1); PG8_STAGE(PG8_SB(0, 0), b2, voffB);
            PG8_BAR; PG8_WAIT_L(0); PG8_MMA(0, 1, At, B1); PG8_BAR;
            PG8_LDA(At, 0, 1); PG8_STAGE(PG8_SA(0, 0), a2, voffA);
            PG8_BAR; PG8_WAIT_L(0); PG8_MMA(1, 0, At, B0); PG8_BAR; PG8_SCHED;
            PG8_STAGE(PG8_SB(0, 1), b2 + hstep, voffB);
            PG8_WAIT_V(6); PG8_BAR; PG8_MMA(1, 1, At, B1); PG8_BAR;
            PG8_LDB(B0, 1, 0); PG8_SCHED; PG8_LDA(At, 1, 0); PG8_STAGE(PG8_SA(0, 1), a2 + hstep, voffA);
            PG8_WAIT_L(8); PG8_BAR; PG8_WAIT_L(0); PG8_MMA(0, 0, At, B0); PG8_BAR; PG8_SCHED;
            PG8_LDB(B1, 1, 1); PG8_STAGE(PG8_SB(1, 0), b3, voffB);
            PG8_BAR; PG8_WAIT_L(0); PG8_MMA(0, 1, At, B1); PG8_BAR;
            PG8_LDA(At, 1, 1); PG8_STAGE(PG8_SA(1, 0), a3, voffA);
            PG8_BAR; PG8_WAIT_L(0); PG8_MMA(1, 0, At, B0); PG8_BAR; PG8_SCHED;
            PG8_STAGE(PG8_SB(1, 1), b3 + hstep, voffB);
            PG8_WAIT_V(6); PG8_BAR; PG8_MMA(1, 1, At, B1); PG8_BAR;
            }
        }
        if constexpr (ALIGN_EPI) { if (wr == 0) PG8_BAR; }
        if constexpr (!Epi::AFTER_DRAIN) { E(acc, cur, wr, wc, fr, fq); S.done(cur); }
        if (!has_next) break;
#pragma unroll
        for (int a = 0; a < 2; ++a)
#pragma unroll
            for (int b = 0; b < 2; ++b)
#pragma unroll
                for (int m = 0; m < 4; ++m)
#pragma unroll
                    for (int n = 0; n < 2; ++n) acc[a][b][m][n] = (f32x4){0.f, 0.f, 0.f, 0.f};
        cur = nxt; cA = nA; cB = nB; ++ui;
        if constexpr (ALIGN_EPI) { if (wr == 1) PG8_BAR; }
    }
    PG8_WAIT_V(0);
    if constexpr (!ALIGN_EPI) { if (wr == 0) PG8_BAR; }
    PG8_BAR;
    if constexpr (Epi::AFTER_DRAIN) { E.fused(acc, cur, wr, wc, fr, fq, lds, wid, lane); S.done(cur); }
#undef PG8_SA
#undef PG8_SB
#undef PG8_STAGE
#undef PG8_LDA
#undef PG8_LDB
#undef PG8_MMA
#undef PG8_WAIT_V
#undef PG8_WAIT_L
#undef PG8_BAR
#undef PG8_SCHED
}
}
#define LAS __attribute__((address_space(3)))
typedef unsigned short bf16_t;
typedef short bf16x8 __attribute__((ext_vector_type(8)));
typedef short s16x4 __attribute__((ext_vector_type(4)));
typedef float f32x4 __attribute__((ext_vector_type(4)));
typedef float f32x16 __attribute__((ext_vector_type(16)));
typedef unsigned u32x4 __attribute__((ext_vector_type(4)));
typedef unsigned u32x2 __attribute__((ext_vector_type(2)));
using pg8::cvt_pk_bf16;

constexpr int NB = 8, S = 4096, D = 1024, M = NB * S, FF = 2816, NQKV = 4608;
constexpr float LAM_INIT = 0.35550906759096934f;
constexpr size_t MiB = 1u << 20;
constexpr size_t WS_MODS = 0, WS_ROPE = 1 * MiB, WS_SSQ = 3 * MiB, WS_LSE = 5 * MiB;
constexpr size_t WS_WQKV = 8 * MiB, WS_WOA = 17 * MiB, WS_WG0 = 18 * MiB, WS_WU0 = WS_WG0 + 5767168, WS_WD0 = WS_WU0 + 5767168, WS_WG1 = WS_WD0 + 5767168, WS_WU1 = WS_WG1 + 5767168, WS_WD1 = WS_WU1 + 5767168;
constexpr size_t WS_WKV = 53 * MiB, WS_WQ1 = 57 * MiB, WS_WOB = 59 * MiB;
static_assert(WS_WD1 + 5767168 <= WS_WKV && WS_WOB + 2 * MiB <= 64 * MiB, "weights map");
constexpr size_t WS_H = 64 * MiB, WS_R = 128 * MiB, WS_END = 512 * MiB;
constexpr int LDS_BYTES = 147456;
constexpr size_t WS_BAR = 507904, BAR_ZERO_BYTES = 16384;
constexpr int LDS_MISC = 131072 + 64;

__device__ __forceinline__ float wave_sum(float v) {
#pragma unroll
    for (int o = 1; o < 64; o <<= 1) v += __shfl_xor(v, o);
    return v;
}
__device__ __forceinline__ float bflo(unsigned w) { return __uint_as_float(w << 16); }
__device__ __forceinline__ float bfhi(unsigned w) { return __uint_as_float(w & 0xffff0000u); }

#define XB_TMO      128
#define XB_XCNT(j)  (256  + 64 * (j))
#define XB_XSUB(j)  (1280 + 64 * (j))
#define XB_XGEN(j)  (2304 + 64 * (j))
#define XB_TOP      3328
#define XB_TOPGEN   3392
#define XCD_BAR_WORDS 3456
#define XB_SPIN_CAP (1u << 18)

__device__ __forceinline__ unsigned xb_ld(unsigned* p)              { return __hip_atomic_load(p, __ATOMIC_RELAXED, __HIP_MEMORY_SCOPE_AGENT); }
__device__ __forceinline__ unsigned xb_add(unsigned* p, unsigned v) { return __hip_atomic_fetch_add(p, v, __ATOMIC_RELAXED, __HIP_MEMORY_SCOPE_AGENT); }
__device__ __forceinline__ unsigned xb_xcc_id() { return (unsigned)__builtin_amdgcn_s_getreg((3 << 11) | 20) & 0xFu; }
#define XB_SPIN(cond, bar) do { unsigned _sp = 0; while (cond) { __builtin_amdgcn_s_sleep(1); \
    if ((++_sp & 255u) == 0u) { if (xb_ld(&(bar)[XB_TMO])) break; if (_sp > XB_SPIN_CAP) { atomicAdd(&(bar)[XB_TMO], 1u); break; } } } } while (0)

struct XcdBarrier {
    unsigned* bar; unsigned x;
    volatile LAS unsigned* st;
};

__device__ __forceinline__ XcdBarrier xcd_barrier_post(unsigned* bar, volatile LAS unsigned* st) {
    XcdBarrier b; b.bar = bar; b.x = xb_xcc_id(); b.st = st;
    if (threadIdx.x == 0) (void)xb_add(&bar[XB_XCNT(b.x)], 1u);
    return b;
}
__device__ __forceinline__ void xcd_barrier_complete(unsigned* bar, unsigned x, unsigned& nloc, unsigned& nx) {
    const unsigned G = gridDim.x * gridDim.y * gridDim.z;
    unsigned sum, cnt, mine, sp = 0u;
    for (;;) {
        sum = 0u; cnt = 0u; mine = 0u;
#pragma unroll
        for (unsigned j = 0; j < 16; ++j) { const unsigned c = xb_ld(&bar[XB_XCNT(j)]); sum += c; cnt += (c > 0u) ? 1u : 0u; mine = (j == x) ? c : mine; }
        if (sum == G) break;
        __builtin_amdgcn_s_sleep(1);
        if ((++sp & 255u) == 0u) { if (xb_ld(&bar[XB_TMO])) break; if (sp > XB_SPIN_CAP) { atomicAdd(&bar[XB_TMO], 1u); break; } }
    }
    nloc = mine > 0u ? mine : 1u; nx = cnt > 0u ? cnt : 1u;
}

__device__ __forceinline__ void xcd_barrier(const XcdBarrier& b) {
    asm volatile("s_waitcnt vmcnt(0)" ::: "memory");
    __syncthreads();
    if (threadIdx.x == 0) {
        unsigned* bar = b.bar;
        __builtin_amdgcn_s_waitcnt(0);
        unsigned nloc = b.st[0], nx = b.st[1];
        if (nloc == 0u) { xcd_barrier_complete(bar, b.x, nloc, nx); b.st[0] = nloc; b.st[1] = nx; }
        const unsigned old = xb_add(&bar[XB_XSUB(b.x)], 1u);
        const unsigned gen = old / nloc;
        if (old + 1u == (gen + 1u) * nloc) {
            __builtin_amdgcn_fence(__ATOMIC_RELEASE, "agent");
            asm volatile("s_waitcnt vmcnt(0)" ::: "memory");
            const unsigned og = xb_add(&bar[XB_TOP], 1u);
            const unsigned tg = og / nx;
            if (og + 1u == (tg + 1u) * nx) xb_add(&bar[XB_TOPGEN], 1u);
            else XB_SPIN(xb_ld(&bar[XB_TOPGEN]) == tg, bar);
            __builtin_amdgcn_fence(__ATOMIC_ACQUIRE, "agent");
            xb_add(&bar[XB_XGEN(b.x)], 1u);
            asm volatile("s_waitcnt vmcnt(0)" ::: "memory");
        } else {
            XB_SPIN(xb_ld(&bar[XB_XGEN(b.x)]) == gen, bar);
            __builtin_amdgcn_fence(__ATOMIC_ACQUIRE, "agent");
            asm volatile("s_waitcnt vmcnt(0)" ::: "memory");
        }
    }
    __syncthreads();
}

template <int DV, bool WINDOW>
__device__ __forceinline__ void attn_core(LAS unsigned char* lds, const bf16_t* Qp, size_t ldq, const bf16_t* Kp, size_t ldk, const bf16_t* Vp, size_t ldv, int i0,
                                          f32x16 (&o)[DV / 32], float& m_run, float& l_run) {
    constexpr int KROW = 144, VROW = DV * 2 + 64, KBYTES = 64 * KROW, VBYTES = 64 * VROW, STAGE = KBYTES + VBYTES, NV = DV / 64, NO = DV / 32;
    int tid_l = threadIdx.x; asm volatile("" : "+v"(tid_l));
    const int tid = tid_l, lane = tid & 63, wid = __builtin_amdgcn_readfirstlane(tid >> 6), r32 = lane & 31, hi = lane >> 5;
    const bf16_t* qrow = Qp + (size_t)(wid * 32 + r32) * ldq + hi * 8;
    bf16x8 qf[4];
#pragma unroll
    for (int d0 = 0; d0 < 4; ++d0) qf[d0] = *(const bf16x8*)(qrow + d0 * 16);
    const int qmin = i0 + wid * 32, qi = qmin + r32;
    const int t_lo = WINDOW ? (((i0 >> 6) - 2) > 0 ? ((i0 >> 6) - 2) : 0) : 0, t_hi = (i0 >> 6) + 4;
    const int wt_lo = WINDOW ? ((((qmin - 128) >> 6) > 0) ? ((qmin - 128) >> 6) : 0) : 0, wt_hi = ((qmin + 31) >> 6) + 1;
    const int skey = tid >> 3, sch = tid & 7;
    const bf16_t* kg = Kp + (size_t)skey * ldk + sch * 8;
    const bf16_t* vg = Vp + (size_t)skey * ldv + sch * 8;
    LAS unsigned char* ks = lds + skey * KROW + sch * 16;
    LAS unsigned char* vs = lds + KBYTES + skey * VROW + sch * 16;
    const LAS unsigned char* kr = lds + r32 * KROW + hi * 16;
    const LAS unsigned char* vr = lds + KBYTES + (4 * hi + ((lane & 15) >> 2)) * VROW + (((lane >> 4) & 1) * 16 + (lane & 3) * 4) * 2;
#pragma unroll
    for (int i = 0; i < NO; ++i)
#pragma unroll
        for (int r = 0; r < 16; ++r) o[i][r] = 0.f;
    float mr = 0.f, lr = 0.f; bool started = false;
    f32x16 negm;
#pragma unroll
    for (int r = 0; r < 16; ++r) negm[r] = 0.f;
    u32x4 kreg, vreg[NV];
    bf16x8 pf[4];
#pragma unroll
    for (int s = 0; s < 4; ++s) pf[s] = (bf16x8){0, 0, 0, 0, 0, 0, 0, 0};
#define ATT_SBAR() __builtin_amdgcn_sched_barrier(0)
#define ATT_GLOAD(t) do { if (WINDOW) { kreg = __builtin_nontemporal_load((const u32x4*)(kg + (size_t)(t) * 64 * ldk)); _Pragma("unroll") for (int i_ = 0; i_ < NV; ++i_) vreg[i_] = __builtin_nontemporal_load((const u32x4*)(vg + (size_t)(t) * 64 * ldv + i_ * 64)); } \
        else { kreg = *(const u32x4*)(kg + (size_t)(t) * 64 * ldk); _Pragma("unroll") for (int i_ = 0; i_ < NV; ++i_) vreg[i_] = *(const u32x4*)(vg + (size_t)(t) * 64 * ldv + i_ * 64); } } while (0)
#define ATT_LSTORE(so) do { *(LAS u32x4*)(ks + (so)) = kreg; _Pragma("unroll") for (int i_ = 0; i_ < NV; ++i_) *(LAS u32x4*)(vs + (so) + i_ * 128) = vreg[i_]; } while (0)
#define ATT_VREAD2(dst, c_) do { _Pragma("unroll") for (int j_ = 0; j_ < 2; ++j_) { const int i_ = 2 * ((c_) % (NO / 2)) + j_; const LAS unsigned char* ap_ = vb_ + (16 * ((c_) / (NO / 2))) * VROW + i_ * 64; \
        const s16x4 lo_ = __builtin_bit_cast(s16x4, __builtin_amdgcn_ds_read_tr16_b64_v4i16((LAS s16x4*)ap_)); \
        const s16x4 h4_ = __builtin_bit_cast(s16x4, __builtin_amdgcn_ds_read_tr16_b64_v4i16((LAS s16x4*)(ap_ + 8 * VROW))); \
        dst[j_] = (bf16x8){lo_[0], lo_[1], lo_[2], lo_[3], h4_[0], h4_[1], h4_[2], h4_[3]}; } } while (0)
#define ATT_PV2(src, c_) do { _Pragma("unroll") for (int j_ = 0; j_ < 2; ++j_) { const int i_ = 2 * ((c_) % (NO / 2)) + j_; o[i_] = __builtin_amdgcn_mfma_f32_32x32x16_bf16(src[j_], pf[(c_) / (NO / 2)], o[i_], 0, 0, 0); } } while (0)
#define ATT_MFMA_C(dst, a_, b_, c_) asm volatile("v_mfma_f32_32x32x16_bf16 %0, %1, %2, %3" : "=&v"(dst) : "v"(a_), "v"(b_), "v"(c_))
#define ATT_SPART(so_) do { const LAS unsigned char* kb_ = kr + (so_); bf16x8 kf_[2][2]; \
        kf_[0][0] = *(const LAS bf16x8*)(kb_); kf_[0][1] = *(const LAS bf16x8*)(kb_ + 32 * KROW); \
        ATT_SBAR(); \
        _Pragma("unroll") for (int d0 = 0; d0 < 4; ++d0) { \
            if (d0 + 1 < 4) { kf_[(d0 + 1) & 1][0] = *(const LAS bf16x8*)(kb_ + (d0 + 1) * 32); kf_[(d0 + 1) & 1][1] = *(const LAS bf16x8*)(kb_ + 32 * KROW + (d0 + 1) * 32); } \
            ATT_SBAR(); \
            if (d0 == 0) { ATT_MFMA_C(p0, kf_[0][0], qf[0], negm); ATT_MFMA_C(p1, kf_[0][1], qf[0], negm); } \
            else { p0 = __builtin_amdgcn_mfma_f32_32x32x16_bf16(kf_[d0 & 1][0], qf[d0], p0, 0, 0, 0); p1 = __builtin_amdgcn_mfma_f32_32x32x16_bf16(kf_[d0 & 1][1], qf[d0], p1, 0, 0, 0); } \
            ATT_SBAR(); } } while (0)
#define ATT_PVPART(so_) do { const LAS unsigned char* vb_ = vr + (so_); bf16x8 vf_[2][2]; constexpr int NCH_ = 4 * (NO / 2); \
        ATT_VREAD2(vf_[0], 0); ATT_SBAR(); \
        _Pragma("unroll") for (int c_ = 0; c_ < NCH_; ++c_) { if (c_ + 1 < NCH_) { ATT_VREAD2(vf_[(c_ + 1) & 1], c_ + 1); } ATT_SBAR(); ATT_PV2(vf_[c_ & 1], c_); ATT_SBAR(); } } while (0)
#define ATT_SOFTMAX(t_) do { \
            const int tk = (t_) * 64; \
            const bool needmask = WINDOW ? !((tk + 63 <= qmin) && (tk >= qmin + 31 - 128)) : (tk + 63 > qmin); \
            if (needmask) { \
                _Pragma("unroll") for (int r = 0; r < 16; ++r) { \
                    const int kk = tk + 4 * hi + (r & 3) + 8 * (r >> 2); \
                    const bool ok0 = (kk <= qi) && (!WINDOW || kk >= qi - 128); \
                    const bool ok1 = (kk + 32 <= qi) && (!WINDOW || kk + 32 >= qi - 128); \
                    p0[r] = ok0 ? p0[r] : -1e30f; p1[r] = ok1 ? p1[r] : -1e30f; } } \
            float mx; { float ma = __builtin_fmaxf(__builtin_fmaxf(p0[0], p0[1]), p1[0]), mb = __builtin_fmaxf(__builtin_fmaxf(p0[2], p0[3]), p1[1]); ma = __builtin_fmaxf(__builtin_fmaxf(ma, p1[2]), p1[3]); \
              _Pragma("unroll") for (int r = 4; r < 16; r += 4) { ma = __builtin_fmaxf(__builtin_fmaxf(ma, p0[r]), p0[r + 1]); mb = __builtin_fmaxf(__builtin_fmaxf(mb, p0[r + 2]), p0[r + 3]); ma = __builtin_fmaxf(__builtin_fmaxf(ma, p1[r]), p1[r + 1]); mb = __builtin_fmaxf(__builtin_fmaxf(mb, p1[r + 2]), p1[r + 3]); } \
              mx = __builtin_fmaxf(ma, mb); } \
            { auto rr = __builtin_amdgcn_permlane32_swap(__float_as_uint(mx), __float_as_uint(mx), false, false); mx = fmaxf(__uint_as_float(rr[0]), __uint_as_float(rr[1])); } \
            if (!started) { started = true; mr = mx; _Pragma("unroll") for (int r = 0; r < 16; ++r) negm[r] = -mx; \
                _Pragma("unroll") for (int r = 0; r < 16; ++r) { p0[r] -= mx; p1[r] -= mx; } \
            } else if (__builtin_amdgcn_ballot_w64(mx > 8.0f) != 0ull) { \
                const float dl = (mx > 8.0f) ? mx : 0.f; mr += dl; _Pragma("unroll") for (int r = 0; r < 16; ++r) negm[r] = -mr; \
                const float alpha = __builtin_amdgcn_exp2f(-dl); lr *= alpha; \
                _Pragma("unroll") for (int r = 0; r < 16; ++r) { p0[r] -= dl; p1[r] -= dl; } \
                _Pragma("unroll") for (int i = 0; i < NO; ++i) _Pragma("unroll") for (int r = 0; r < 16; ++r) o[i][r] *= alpha; } \
            _Pragma("unroll") for (int r = 0; r < 16; ++r) { p0[r] = __builtin_amdgcn_exp2f(p0[r]); p1[r] = __builtin_amdgcn_exp2f(p1[r]); }     \
            { float sa = p0[0] + p1[0], sb = p0[1] + p1[1], sc = p0[2] + p1[2], sd = p0[3] + p1[3];                                               \
              _Pragma("unroll") for (int r = 4; r < 16; r += 4) { sa += p0[r] + p1[r]; sb += p0[r + 1] + p1[r + 1]; sc += p0[r + 2] + p1[r + 2]; sd += p0[r + 3] + p1[r + 3]; } \
              lr += (sa + sb) + (sc + sd); } \
            { u32x4 w; \
              w.x = cvt_pk_bf16(p0[0], p0[1]); w.y = cvt_pk_bf16(p0[2], p0[3]); w.z = cvt_pk_bf16(p0[4], p0[5]); w.w = cvt_pk_bf16(p0[6], p0[7]); pf[0] = __builtin_bit_cast(bf16x8, w); \
              w.x = cvt_pk_bf16(p0[8], p0[9]); w.y = cvt_pk_bf16(p0[10], p0[11]); w.z = cvt_pk_bf16(p0[12], p0[13]); w.w = cvt_pk_bf16(p0[14], p0[15]); pf[1] = __builtin_bit_cast(bf16x8, w); \
              w.x = cvt_pk_bf16(p1[0], p1[1]); w.y = cvt_pk_bf16(p1[2], p1[3]); w.z = cvt_pk_bf16(p1[4], p1[5]); w.w = cvt_pk_bf16(p1[6], p1[7]); pf[2] = __builtin_bit_cast(bf16x8, w); \
              w.x = cvt_pk_bf16(p1[8], p1[9]); w.y = cvt_pk_bf16(p1[10], p1[11]); w.z = cvt_pk_bf16(p1[12], p1[13]); w.w = cvt_pk_bf16(p1[14], p1[15]); pf[3] = __builtin_bit_cast(bf16x8, w); } \
            ATT_SBAR(); } while (0)
#ifndef LAGSEL
#define LAGSEL (wid >= 4)
#endif
    const bool lag = LAGSEL;
    ATT_GLOAD(t_lo); ATT_LSTORE(0);
    asm volatile("" : "+v"(qf[0]), "+v"(qf[1]), "+v"(qf[2]), "+v"(qf[3]));
    __syncthreads();
    int so_p = 2 * STAGE, so_c = 0, so_n = STAGE;
    bool pend = false;
    for (int t = t_lo; t < t_hi; ++t) {
        const bool more = (t + 1 < t_hi);
        if (more) ATT_GLOAD(t + 1);
        const bool inr = (t >= wt_lo && t < wt_hi);
        if (pend) { ATT_PVPART(so_p); }
#if defined(EXP_DUPS)
        if (inr) { f32x16 p0, p1; ATT_SPART(so_c); asm volatile("" : "+v"(p0), "+v"(p1)); ATT_SPART(so_c); ATT_SOFTMAX(t); }
#else
        if (inr) { f32x16 p0, p1; ATT_SPART(so_c); ATT_SOFTMAX(t); }
#endif
        if (!lag && inr) { ATT_PVPART(so_c); }
        pend = lag && inr;
        if (more) ATT_LSTORE(so_n);
        __syncthreads();
#if defined(EXP_DUPB)
        asm volatile("s_nop 0" ::: "memory"); __syncthreads();
#endif
        { const int tmp = so_p; so_p = so_c; so_c = so_n; so_n = tmp; }
    }
    if (pend) { ATT_PVPART(so_p); }
    __syncthreads();
#undef ATT_SBAR
#undef ATT_GLOAD
#undef ATT_LSTORE
#undef ATT_VREAD2
#undef ATT_PV2
#undef ATT_SPART
#undef ATT_MFMA_C
#undef ATT_PVPART
#undef ATT_SOFTMAX
    m_run = mr; l_run = lr + __shfl_xor(lr, 32);
}

#ifndef ONLY
#define PH(k) true
#else
#define PH(k) ((ONLY) == (k))
#endif
#ifndef DUP_K
#define DUP_K (-1)
#endif
#define GSYNC() do { xcd_barrier(xbar); if (DUP_K == 9) xcd_barrier(xbar); } while (0)
#define REP(k) for (int rep_ = 0; rep_ < ((DUP_K == (k)) ? 2 : 1); ++rep_)
#ifdef PROBE_R
#define STAMP(k) do { if (blockIdx.x == 0 && threadIdx.x == 0) ((unsigned long long*)(a.ws + 520192))[k] = __builtin_amdgcn_s_memrealtime(); } while (0)
#else
#define STAMP(k) do {} while (0)
#endif
struct Args { const void* in[30]; float* out; unsigned char* ws; };

__device__ __forceinline__ int permcol(int n, int pmode) {
    if (pmode == 3) return 256 * (n >> 7) + (n & 127);
    if (pmode == 4) return 256 * (n >> 7) + 128 + (n & 127);
    const bool rot = (pmode == 1) || (pmode == 2 && (n % 1536) < 1024);
    const int nn = n & 63;
    if (rot && nn < 16) return (n & ~63) + 2 * (nn & 7) + (nn >> 3);
    return n;
}
__device__ __forceinline__ void transpose_item(const float* W, int K, int N, bf16_t* WT, int row_off, int pmode, LAS float* scr, int item, int lane) {
    const int nblk = N / 32, kb = item / nblk, nb = item % nblk, k0 = 64 * kb, n0 = 32 * nb;
#pragma unroll
    for (int i = 0; i < 32; ++i) { const int kk = 2 * i + (lane >> 5); scr[kk * 33 + (lane & 31)] = __builtin_nontemporal_load(W + (size_t)(k0 + kk) * N + n0 + (lane & 31)); }
    asm volatile("s_waitcnt lgkmcnt(0)" ::: "memory");
    const int c = lane & 7;
#pragma unroll
    for (int j = 0; j < 4; ++j) { const int n = (lane >> 3) + 8 * j; const LAS float* s = scr + (8 * c) * 33 + n;
        u32x4 o; o.x = cvt_pk_bf16(s[0 * 33], s[1 * 33]); o.y = cvt_pk_bf16(s[2 * 33], s[3 * 33]); o.z = cvt_pk_bf16(s[4 * 33], s[5 * 33]); o.w = cvt_pk_bf16(s[6 * 33], s[7 * 33]);
        *(u32x4*)(WT + (size_t)(row_off + permcol(n0 + n, pmode)) * K + k0 + 8 * c) = o; }
    asm volatile("s_waitcnt lgkmcnt(0)" ::: "memory");
}

__device__ __forceinline__ f32x4 ld4(const float* p) { return *(const f32x4*)p; }

template <bool HAS_Y, int NH, bool PERMROWS = false, bool XIN_BF = false, bool XOUT_BF = false>
__device__ __forceinline__ void thin_pass(int gw, int NGW, int lane, const void* xin_v, void* xout_v, const bf16_t* Y, const float* ssqp,
                                          const float* gpost, const float* gate,
                                          const float* g1, const float* sc1, const float* sh1, bf16_t* H1,
                                          const float* g2, const float* sc2, const float* sh2, bf16_t* H2) {
    asm volatile("" : "+v"(lane));
    const int rpw = (M + NGW - 1) / NGW; const int r0 = gw * rpw; const int r1 = (r0 + rpw < M) ? (r0 + rpw) : M;
    int curb = -1; f32x4 GG[4], A1[4], B1[4], A2[4], B2[4];
    typedef typename std::conditional<XIN_BF, u32x2, f32x4>::type xraw_t;
    xraw_t xn[4]; u32x2 yn[4]; float pvn = 0.f;
#define TP_LOAD(row_) do { _Pragma("unroll") for (int j = 0; j < 4; ++j) { \
              \
            if (XIN_BF) xn[j] = __builtin_nontemporal_load((const xraw_t*)((const bf16_t*)xin_v + (size_t)(row_) * D + 4 * lane + 256 * j)); else xn[j] = __builtin_nontemporal_load((const xraw_t*)((const float*)xin_v + (size_t)(row_) * D + 4 * lane + 256 * j)); \
            if (HAS_Y) yn[j] = __builtin_nontemporal_load((const u32x2*)(Y + (size_t)(row_) * D + 4 * lane + 256 * j)); } \
        if (HAS_Y) pvn = (lane < 16) ? ssqp[(size_t)(row_) * 16 + lane] : 0.f; } while (0)
    if (r0 < r1) TP_LOAD(r0);
    for (int row = r0; row < r1; ++row) {
        const int b = row >> 12;
        if (b != curb) { curb = b;
#pragma unroll
            for (int j = 0; j < 4; ++j) { const int c = 4 * lane + 256 * j;
                if (HAS_Y) GG[j] = ld4(gpost + c) * ld4(gate + b * 3072 + c);
                if (NH >= 1) { A1[j] = ld4(g1 + c) * (ld4(sc1 + b * 3072 + c) + 1.0f); B1[j] = ld4(sh1 + b * 3072 + c); }
                if (NH >= 2) { A2[j] = ld4(g2 + c) * (ld4(sc2 + b * 3072 + c) + 1.0f); B2[j] = ld4(sh2 + b * 3072 + c); } } }
        xraw_t xc[4]; u32x2 yc[4]; const float pvc = pvn;
#pragma unroll
        for (int j = 0; j < 4; ++j) { xc[j] = xn[j]; yc[j] = yn[j]; }
        if (row + 1 < r1) TP_LOAD(row + 1);
        f32x4 x[4];
#pragma unroll
        for (int j = 0; j < 4; ++j) {
            if (XIN_BF) { const u32x2 xw = __builtin_bit_cast(u32x2, *(const u32x2*)&xc[j]); x[j] = (f32x4){bflo(xw.x), bfhi(xw.x), bflo(xw.y), bfhi(xw.y)}; }
            else x[j] = *(const f32x4*)&xc[j];
        }
        if (HAS_Y) {
            f32x4 y[4];
#pragma unroll
            for (int j = 0; j < 4; ++j) { const u32x2 yw = yc[j]; y[j] = (f32x4){bflo(yw.x), bfhi(yw.x), bflo(yw.y), bfhi(yw.y)}; }
            const float rs = 1.0f / sqrtf(wave_sum(pvc) * (1.0f / D) + 1e-6f);
#pragma unroll
            for (int j = 0; j < 4; ++j) { x[j] = x[j] + GG[j] * (y[j] * rs);
                if (XOUT_BF) { u32x2 w; w.x = cvt_pk_bf16(x[j][0], x[j][1]); w.y = cvt_pk_bf16(x[j][2], x[j][3]); __builtin_nontemporal_store(w, (u32x2*)((bf16_t*)xout_v + (size_t)row * D + 4 * lane + 256 * j)); }
                else __builtin_nontemporal_store(x[j], (f32x4*)((float*)xout_v + (size_t)row * D + 4 * lane + 256 * j)); }
        }
        if (NH >= 1) {
            float s = 0.f;
#pragma unroll
            for (int j = 0; j < 4; ++j) s += (x[j][0] * x[j][0] + x[j][1] * x[j][1]) + (x[j][2] * x[j][2] + x[j][3] * x[j][3]);
            const float rstd = 1.0f / sqrtf(wave_sum(s) * (1.0f / D) + 1e-6f);
            int hrow = row;
            if (PERMROWS) { const int t = row & 255; hrow = (row & ~255) + 128 * ((t >> 2) & 1) + 64 * (t >> 7) + 16 * (t & 3) + ((t >> 3) & 15); }
#pragma unroll
            for (int j = 0; j < 4; ++j) { const f32x4 h = (x[j] * rstd) * A1[j] + B1[j]; u32x2 w; w.x = cvt_pk_bf16(h[0], h[1]); w.y = cvt_pk_bf16(h[2], h[3]);
                *(u32x2*)(H1 + (size_t)hrow * D + 4 * lane + 256 * j) = w; }
            if (NH >= 2) {
#pragma unroll
                for (int j = 0; j < 4; ++j) { const f32x4 h = (x[j] * rstd) * A2[j] + B2[j]; u32x2 w; w.x = cvt_pk_bf16(h[0], h[1]); w.y = cvt_pk_bf16(h[2], h[3]);
                    *(u32x2*)(H2 + (size_t)row * D + 4 * lane + 256 * j) = w; }
            }
        }
    }
#undef TP_LOAD
}

__global__ void __launch_bounds__(512, 2) mk_fwd(Args a) {
    extern __shared__ __attribute__((aligned(16))) unsigned char lds_raw[];
    LAS unsigned char* lds = (LAS unsigned char*)lds_raw;
    cg::grid_group grid = cg::this_grid();
    const int tid = threadIdx.x, lane = tid & 63, wave = __builtin_amdgcn_readfirstlane(tid >> 6);
    const int G = gridDim.x, bx = blockIdx.x;
    const int vcu = (G % 8 == 0) ? (bx % 8) * (G / 8) + bx / 8 : bx;
    const int gw = vcu * 8 + wave, NGW = G * 8;
    unsigned char* ws = a.ws;
    if (tid < 16) ((LAS unsigned*)(lds + LDS_MISC))[tid] = 0u;
    __syncthreads();
    if (bx == 0) { for (int i = tid; i < (int)(BAR_ZERO_BYTES / 4); i += 512) ((unsigned*)(ws + WS_BAR))[i] = 0u; __threadfence(); }
    const float* x_in = (const float*)a.in[0];
    const float* c_in = (const float*)a.in[1];
    const int* pos_in = (const int*)a.in[2];
    const float* mod_mix_w = (const float*)a.in[3]; const float* mod_mix_b = (const float*)a.in[4];
    const float* mod_ffn_w = (const float*)a.in[5]; const float* mod_ffn_b = (const float*)a.in[6];
    const float* norm_pre_mix = (const float*)a.in[7]; const float* norm_post_mix = (const float*)a.in[8];
    const float* norm_pre_ffn = (const float*)a.in[9]; const float* norm_post_ffn = (const float*)a.in[10];
    const float* ffn_w_gate = (const float*)a.in[11]; const float* ffn_w_up = (const float*)a.in[12];
    const float* ffn_conv_w = (const float*)a.in[13]; const float* ffn_conv_b = (const float*)a.in[14];
    const float* ffn_w_down = (const float*)a.in[15];
    const float* a_w_qkv = (const float*)a.in[16]; const float* a_w_o = (const float*)a.in[17];
    const float* kv_norm = (const float*)a.in[18]; const float* kv_mod_w = (const float*)a.in[19]; const float* kv_mod_b = (const float*)a.in[20];
    const float* b_w_k = (const float*)a.in[21]; const float* b_w_v = (const float*)a.in[22]; const float* b_w_q = (const float*)a.in[23];
    const float* lq1 = (const float*)a.in[24]; const float* lk1 = (const float*)a.in[25]; const float* lq2 = (const float*)a.in[26]; const float* lk2 = (const float*)a.in[27];
    const float* b_subln = (const float*)a.in[28]; const float* b_w_o = (const float*)a.in[29];
    float* out = a.out;
    float* MODS = (float*)(ws + WS_MODS);
    float* ROPE = (float*)(ws + WS_ROPE);
    float* SSQ = (float*)(ws + WS_SSQ);
    float* LSE = (float*)(ws + WS_LSE);
    bf16_t* WQKV = (bf16_t*)(ws + WS_WQKV); bf16_t* WOA = (bf16_t*)(ws + WS_WOA);
    bf16_t* WKV = (bf16_t*)(ws + WS_WKV); bf16_t* WQ1 = (bf16_t*)(ws + WS_WQ1); bf16_t* WOB = (bf16_t*)(ws + WS_WOB);
    bf16_t* Hb = (bf16_t*)(ws + WS_H);
    unsigned char* R = ws + WS_R;
    bf16_t* X1 = (bf16_t*)out; bf16_t* X2 = (bf16_t*)out + (size_t)M * D; bf16_t* X3 = (bf16_t*)(R + 96 * MiB);

    STAMP(0);
    REP(6) { __syncthreads();
    if (PH(0) && bx < 224) {
        const float* W; const float* bias; int ldw, col0; float* mo;
        if (bx < 192) { const int mat = bx / 48, cb = bx % 48; const int l = mat >> 1; col0 = cb * 64; ldw = 3072;
            W = ((mat & 1) ? mod_ffn_w : mod_mix_w) + (size_t)l * D * 3072; bias = ((mat & 1) ? mod_ffn_b : mod_mix_b) + l * 3072; mo = MODS + (size_t)mat * 8 * 3072; }
        else { const int cb = bx - 192; col0 = cb * 64; ldw = 2048; W = kv_mod_w; bias = kv_mod_b; mo = MODS + (size_t)4 * 8 * 3072; }
        LAS float* cact = (LAS float*)lds;
        LAS float* red = (LAS float*)(lds + 32768);
        for (int i = tid; i < 8 * 1024; i += 512) { const int b = i >> 10, k = i & 1023; const float cv = c_in[b * 1024 + k]; cact[k * 8 + b] = cv / (1.0f + __expf(-cv)); }
        __syncthreads();
        float acc[8];
#pragma unroll
        for (int b = 0; b < 8; ++b) acc[b] = 0.f;
        const float* wp = W + (size_t)(wave * 128) * ldw + col0 + lane;
#pragma unroll 16
        for (int k = 0; k < 128; ++k) {
            const float w = __builtin_nontemporal_load(wp + (size_t)k * ldw);
            const f32x4 c0 = *(const LAS f32x4*)(cact + (wave * 128 + k) * 8), c1 = *(const LAS f32x4*)(cact + (wave * 128 + k) * 8 + 4);
            acc[0] += c0[0] * w; acc[1] += c0[1] * w; acc[2] += c0[2] * w; acc[3] += c0[3] * w;
            acc[4] += c1[0] * w; acc[5] += c1[1] * w; acc[6] += c1[2] * w; acc[7] += c1[3] * w;
        }
#pragma unroll
        for (int b = 0; b < 8; ++b) red[(wave * 8 + b) * 64 + lane] = acc[b];
        __syncthreads();
        { const int b = tid >> 6; float s = bias[col0 + lane];
#pragma unroll
          for (int w = 0; w < 8; ++w) s += red[(w * 8 + b) * 64 + lane];
          mo[b * 3072 + col0 + lane] = s; }
        __syncthreads();
    }
    if (PH(0)) {
        const float invf[8] = {1.0f, 0.1939227432012558f, 0.03760603070259094f, 0.007292664609849453f, 0.0014142135623842478f, 0.00027424818836152554f, 5.318296098266728e-05f, 1.0313386155758053e-05f};
        for (int i = bx * 512 + tid; i < M * 8; i += G * 512) {
            const int row = i >> 3, j = i & 7;
            float iv = invf[0];
#pragma unroll
            for (int q = 1; q < 8; ++q) iv = (j == q) ? invf[q] : iv;
            const float ang = (float)pos_in[row] * iv;
            double rev = (double)ang * 0.15915494309189535; rev -= __builtin_rint(rev);
            const float rf = (float)rev;
            ROPE[(size_t)i * 2] = __builtin_amdgcn_cosf(rf); ROPE[(size_t)i * 2 + 1] = __builtin_amdgcn_sinf(rf);
        }
    }
    if (PH(0)) {
        LAS float* scr = (LAS float*)(lds + wave * 16384);
        constexpr int I_QKV = 16 * 144, I_OA = 8 * 32, I_GU = 16 * 88, I_DN = 44 * 32, I_SQ = 16 * 32;
        constexpr int NITEMS = I_QKV + I_OA + 4 * I_GU + 2 * I_DN + 4 * I_SQ;
        for (int it = gw; it < NITEMS; it += NGW) {
            int r = it;
            if (r < I_QKV) { transpose_item(a_w_qkv, D, NQKV, WQKV, 0, 2, scr, r, lane); continue; } r -= I_QKV;
            if (r < I_OA) { transpose_item(a_w_o, 512, D, WOA, 0, 0, scr, r, lane); continue; } r -= I_OA;
            if (r < 4 * I_GU) { const int w = r / I_GU, l = w >> 1, up = w & 1; r -= w * I_GU;
                transpose_item((up ? ffn_w_up : ffn_w_gate) + (size_t)l * D * FF, D, FF, (bf16_t*)(ws + (l ? WS_WG1 : WS_WG0)), 0, up ? 4 : 3, scr, r, lane); continue; } r -= 4 * I_GU;
            if (r < 2 * I_DN) { const int l = r / I_DN; r -= l * I_DN;
                transpose_item(ffn_w_down + (size_t)l * FF * D, FF, D, (bf16_t*)(ws + (l ? WS_WD1 : WS_WD0)), 0, 0, scr, r, lane); continue; } r -= 2 * I_DN;
            if (r < I_SQ) { transpose_item(b_w_k, D, D, WKV, 0, 1, scr, r, lane); continue; } r -= I_SQ;
            if (r < I_SQ) { transpose_item(b_w_v, D, D, WKV, 1024, 0, scr, r, lane); continue; } r -= I_SQ;
            if (r < I_SQ) { transpose_item(b_w_q, D, D, WQ1, 0, 1, scr, r, lane); continue; } r -= I_SQ;
            transpose_item(b_w_o, D, D, WOB, 0, 0, scr, r, lane);
        }
    }
    if (rep_ > 0) { grid.sync(); } }
    grid.sync();
    const XcdBarrier xbar = xcd_barrier_post((unsigned*)(ws + WS_BAR), (volatile LAS unsigned*)(lds + LDS_MISC));

    REP(5) { if (PH(1)) thin_pass<false, 1>(gw, NGW, lane, x_in, nullptr, nullptr, nullptr, nullptr, nullptr,
                        norm_pre_mix, MODS + 0 * 8 * 3072 + 1024, MODS + 0 * 8 * 3072, Hb, nullptr, nullptr, nullptr, nullptr);
    GSYNC(); } STAMP(1);

    bf16_t* QKV0 = (bf16_t*)R;
    REP(1) { if (PH(2)) {
        pg8::Gemm g{Hb, WQKV, M, NQKV, D}; pg8::StaticOrder So; So.init(M, NQKV, G, bx);
        pg8::EpiRope<0> E{QKV0, NQKV, ROPE, 0};
        pg8::gemm_phase<pg8::EpiRope<0>, pg8::StaticOrder, true, true>(lds, g, So, E);
    }
    GSYNC(); } STAMP(2);

    bf16_t* OG = (bf16_t*)(R + 288 * MiB);
    REP(2) { if (PH(3)) for (int u = vcu; u < 3072; u += G) {
        const int bgh = u >> 4, qblk = u & 15; const int b = bgh / 24, g = (bgh % 24) >> 3, h = bgh & 7;
        const int dil = (g == 0) ? 1 : (g == 1 ? 4 : 16), L = S / dil;
        const int p0 = qblk * 256, rs = p0 / L, i0 = p0 % L;
        const size_t segbase = (size_t)b * S + (size_t)rs * L;
        const bf16_t* Qp = QKV0 + ((size_t)b * S + p0) * NQKV + g * 1536 + h * 64;
        const bf16_t* Kp = QKV0 + segbase * NQKV + g * 1536 + 512 + h * 64;
        const bf16_t* Vp = QKV0 + segbase * NQKV + g * 1536 + 1024 + h * 64;
        f32x16 o[2]; float mr, lr;
        attn_core<64, true>(lds, Qp, NQKV, Kp, NQKV, Vp, NQKV, i0, o, mr, lr);
        const int r32 = lane & 31, hi = lane >> 5;
        const int qi = i0 + wave * 32 + r32;
        const size_t row = (size_t)b * S + (size_t)qi * dil + rs;
        const float inv = 1.0f / lr;
        bf16_t* op = OG + ((size_t)g * M + row) * 512 + h * 64 + 4 * hi;
#pragma unroll
        for (int i = 0; i < 2; ++i)
#pragma unroll
            for (int q4 = 0; q4 < 4; ++q4) { u32x2 w; w.x = cvt_pk_bf16(o[i][4 * q4] * inv, o[i][4 * q4 + 1] * inv); w.y = cvt_pk_bf16(o[i][4 * q4 + 2] * inv, o[i][4 * q4 + 3] * inv);
                *(u32x2*)(op + i * 32 + 8 * q4) = w; }
        if (hi == 0) LSE[((size_t)g * M + row) * 8 + h] = mr + __log2f(lr);
    }
    GSYNC(); } STAMP(3);

    bf16_t* MIX = Hb;
    if (PH(4)) {
        int lane_o = lane; asm volatile("" : "+v"(lane_o)); const int lane = lane_o;
        const int rpw = (M + NGW - 1) / NGW; const int r0 = gw * rpw; const int r1 = (r0 + rpw < M) ? (r0 + rpw) : M;
        for (int row = r0; row < r1; ++row) {
            const int h = lane >> 3;
            const float l0 = LSE[((size_t)0 * M + row) * 8 + h], l1 = LSE[((size_t)1 * M + row) * 8 + h], l2 = LSE[((size_t)2 * M + row) * 8 + h];
            const float mx = fmaxf(l0, fmaxf(l1, l2));
            float w0 = __builtin_amdgcn_exp2f(l0 - mx), w1 = __builtin_amdgcn_exp2f(l1 - mx), w2 = __builtin_amdgcn_exp2f(l2 - mx);
            const float ws_ = 1.0f / (w0 + w1 + w2); w0 *= ws_; w1 *= ws_; w2 *= ws_;
            const u32x4 a0 = __builtin_nontemporal_load((const u32x4*)(OG + ((size_t)0 * M + row) * 512 + 8 * lane)), a1 = __builtin_nontemporal_load((const u32x4*)(OG + ((size_t)1 * M + row) * 512 + 8 * lane)), a2 = __builtin_nontemporal_load((const u32x4*)(OG + ((size_t)2 * M + row) * 512 + 8 * lane));
            u32x4 w;
#pragma unroll
            for (int e = 0; e < 4; ++e) { const float lo = w0 * bflo(a0[e]) + w1 * bflo(a1[e]) + w2 * bflo(a2[e]), hh = w0 * bfhi(a0[e]) + w1 * bfhi(a1[e]) + w2 * bfhi(a2[e]); w[e] = cvt_pk_bf16(lo, hh); }
            *(u32x4*)(MIX + (size_t)row * 512 + 8 * lane) = w;
        }
    }
    GSYNC();

    bf16_t* Y = (bf16_t*)R;
    if (PH(5)) {
        pg8::Gemm g{MIX, WOA, M, D, 512}; pg8::StaticOrder So; So.init(M, D, G, bx);
        pg8::EpiY E{Y, D, SSQ};
        pg8::gemm_phase<pg8::EpiY, pg8::StaticOrder, true, true>(lds, g, So, E);
    }
    GSYNC();

    for (int l = 0; l < 2; ++l) {
        if (l == 1) {
            bf16_t* HK = (bf16_t*)(R + 128 * MiB);
            bf16_t* Kb = (bf16_t*)(R + 192 * MiB);
            bf16_t* Qb = (bf16_t*)R;
            if (PH(6)) {
                pg8::Gemm g{HK, WKV, M, 2048, D}; pg8::StaticOrder So; So.init(M, 2048, G, bx);
                pg8::EpiRope<1> E{Kb, D, ROPE, (size_t)M * D};
                pg8::gemm_phase<pg8::EpiRope<1>, pg8::StaticOrder, true, true>(lds, g, So, E);
            }
            if (PH(7)) {
                pg8::Gemm g{Hb, WQ1, M, D, D}; pg8::StaticOrder So; So.init(M, D, G, bx);
                pg8::EpiRope<2> E{Qb, D, ROPE, 0};
                pg8::gemm_phase<pg8::EpiRope<2>, pg8::StaticOrder, true, true>(lds, g, So, E);
            }
            GSYNC(); STAMP(7);
            bf16_t* Vb = Kb + (size_t)M * D;
            bf16_t* O1 = (bf16_t*)(R + 128 * MiB);
            bf16_t* O2 = (bf16_t*)(R + 64 * MiB);
            REP(3) { if (PH(8)) {
                int lane_o = lane; asm volatile("" : "+v"(lane_o)); const int lane = lane_o;
                const float lv1 = lq1[lane] * lk1[lane], lv2 = lq2[lane] * lk2[lane];
                const float lam = __expf(wave_sum(lv1)) - __expf(wave_sum(lv2)) + LAM_INIT;
                const int per = (1024 + G - 1) / G;
                for (int it = 0; it < per; ++it) {
                    int b, h, qb;
                    if (G == 256) {
                        const int xcd = vcu >> 5, jc = vcu & 31, bh = xcd * 8 + it * 2 + (jc >> 4); b = bh >> 3; h = bh & 7; qb = (it & 1) ? (15 - (jc & 15)) : (jc & 15);
                    } else {
                        const int slot = vcu * per + it; if (slot >= 1024) break;
                        const int combo = slot >> 4, j = slot & 15; qb = (j & 1) ? (15 - (j >> 1)) : (j >> 1); b = combo >> 3; h = combo & 7;
                    }
                    const int r32 = lane & 31, hi = lane >> 5;
                    const size_t row = (size_t)b * S + qb * 256 + wave * 32 + r32;
                    bf16_t* o1p = O1 + row * D + h * 128 + 4 * hi;
#pragma unroll 1
                    for (int cc = 0; cc < 2; ++cc) {
                        const int hc = 2 * h + cc;
                        const bf16_t* Qp = Qb + ((size_t)b * S + qb * 256) * D + hc * 64;
                        const bf16_t* Kp = Kb + ((size_t)b * S) * D + hc * 64;
                        const bf16_t* Vp = Vb + ((size_t)b * S) * D + h * 128;
                        f32x16 o[4]; float mr, lr;
                        attn_core<128, false>(lds, Qp, D, Kp, D, Vp, D, qb * 256, o, mr, lr);
                        const float inv = 1.0f / lr;
                        if (cc == 0) {
#pragma unroll
                            for (int i = 0; i < 4; ++i)
#pragma unroll
                                for (int q4 = 0; q4 < 4; ++q4) { u32x2 w; w.x = cvt_pk_bf16(o[i][4 * q4] * inv, o[i][4 * q4 + 1] * inv); w.y = cvt_pk_bf16(o[i][4 * q4 + 2] * inv, o[i][4 * q4 + 3] * inv); *(u32x2*)(o1p + i * 32 + 8 * q4) = w; }
                        } else {
                            float ss = 0.f;
#pragma unroll
                            for (int i = 0; i < 4; ++i)
#pragma unroll
                                for (int q4 = 0; q4 < 4; ++q4) { const u32x2 w = *(const u32x2*)(o1p + i * 32 + 8 * q4);
                                    const float v0 = bflo(w.x) - lam * (o[i][4 * q4] * inv), v1 = bfhi(w.x) - lam * (o[i][4 * q4 + 1] * inv), v2 = bflo(w.y) - lam * (o[i][4 * q4 + 2] * inv), v3 = bfhi(w.y) - lam * (o[i][4 * q4 + 3] * inv);
                                    o[i][4 * q4] = v0; o[i][4 * q4 + 1] = v1; o[i][4 * q4 + 2] = v2; o[i][4 * q4 + 3] = v3; ss += (v0 * v0 + v1 * v1) + (v2 * v2 + v3 * v3); }
                            ss += __shfl_xor(ss, 32);
                            const float rstd = (1.0f - LAM_INIT) / sqrtf(ss * (1.0f / 128.0f) + 1e-5f);
                            bf16_t* op = Hb + row * D + h * 128 + 4 * hi;
#pragma unroll
                            for (int i = 0; i < 4; ++i)
#pragma unroll
                                for (int q4 = 0; q4 < 4; ++q4) { const f32x4 sg = ld4(b_subln + i * 32 + 8 * q4 + 4 * hi);
                                    u32x2 w; w.x = cvt_pk_bf16(o[i][4 * q4] * rstd * sg[0], o[i][4 * q4 + 1] * rstd * sg[1]); w.y = cvt_pk_bf16(o[i][4 * q4 + 2] * rstd * sg[2], o[i][4 * q4 + 3] * rstd * sg[3]);
                                    *(u32x2*)(op + i * 32 + 8 * q4) = w; }
                        }
                    }
                }
            }
            GSYNC(); } STAMP(8);
            if (PH(10)) {
                pg8::Gemm g{Hb, WOB, M, D, D}; pg8::StaticOrder So; So.init(M, D, G, bx);
                pg8::EpiY E{Y, D, SSQ};
                pg8::gemm_phase<pg8::EpiY, pg8::StaticOrder, true, true>(lds, g, So, E);
            }
            GSYNC();
        }
        if (PH(11)) {
            const float* mm = MODS + (size_t)(2 * l) * 8 * 3072;
            const float* mf = MODS + (size_t)(2 * l + 1) * 8 * 3072;
            if (l == 0) thin_pass<true, 1, true, false, true>(gw, NGW, lane, x_in, X1, Y, SSQ, norm_post_mix, mm + 2048,
                               norm_pre_ffn, mf + 1024, mf, Hb, nullptr, nullptr, nullptr, nullptr);
            else thin_pass<true, 1, true, true, true>(gw, NGW, lane, X2, X3, Y, SSQ, norm_post_mix + D, mm + 2048,
                               norm_pre_ffn + D, mf + 1024, mf, Hb, nullptr, nullptr, nullptr, nullptr);
        }
        GSYNC(); STAMP(l == 0 ? 4 : 9);
        bf16_t* Fb = (bf16_t*)(R + 176 * MiB);
        float* BND = (float*)(R + 64 * MiB);
        float* HALO = (float*)(R + 80 * MiB);
        REP(4) { REP(7) { if (PH(12)) {
            pg8::Gemm g{Hb, (const bf16_t*)(ws + (l ? WS_WG1 : WS_WG0)), M, 2 * FF, D}; pg8::StaticOrder So; So.init(M, 2 * FF, G, bx);
            pg8::EpiGateUp E{Fb, ffn_conv_w + (size_t)l * 3 * FF, ffn_conv_b + (size_t)l * FF, FF, BND, HALO};
            pg8::gemm_phase<pg8::EpiGateUp, pg8::StaticOrder, true, true>(lds, g, So, E);
        }
        GSYNC(); }
        if (PH(13)) {
            const float* cw = ffn_conv_w + (size_t)l * 3 * FF; const float* cb = ffn_conv_b + (size_t)l * FF;
            int tid_o = tid; asm volatile("" : "+v"(tid_o));
            for (int i = bx * 512 + tid_o; i < 512 * (FF / 4); i += G * 512) {
                const int c4 = (i % (FF / 4)) * 4, kj = i / (FF / 4), k = kj >> 1, j = kj & 1;
                const bool first = ((k & 31) == 0);
                const f32x4 z = (f32x4){0.f, 0.f, 0.f, 0.f};
                const f32x4 h6 = first ? z : *(const f32x4*)(HALO + (size_t)((k - 1) * 2 + 0) * FF + c4), h7 = first ? z : *(const f32x4*)(HALO + (size_t)((k - 1) * 2 + 1) * FF + c4);
                const f32x4 a0 = *(const f32x4*)(BND + ((size_t)(k * 2 + 0) * 2 + 0) * FF + c4), a1 = *(const f32x4*)(BND + ((size_t)(k * 2 + 1) * 2 + 0) * FF + c4);
                const f32x4 uu = *(const f32x4*)(BND + ((size_t)(k * 2 + j) * 2 + 1) * FF + c4);
                const f32x4 am2 = j ? h7 : h6, am1 = j ? a0 : h7, aj = j ? a1 : a0;
                const f32x4 cv = ld4(cb + c4) + ld4(cw + c4) * am2 + ld4(cw + FF + c4) * am1 + ld4(cw + 2 * FF + c4) * aj;
                u32x2 w; w.x = cvt_pk_bf16(pg8::gelu_tanh_f(cv[0]) * uu[0], pg8::gelu_tanh_f(cv[1]) * uu[1]); w.y = cvt_pk_bf16(pg8::gelu_tanh_f(cv[2]) * uu[2], pg8::gelu_tanh_f(cv[3]) * uu[3]);
                *(u32x2*)(Fb + (size_t)(k * 128 + j) * FF + c4) = w;
            }
        }
        GSYNC(); if (l == 0) STAMP(5);
        REP(8) { if (PH(14)) {
            pg8::Gemm g{Fb, (const bf16_t*)(ws + (l ? WS_WD1 : WS_WD0)), M, D, FF}; pg8::StaticOrder So; So.init(M, D, G, bx);
            pg8::EpiY E{Y, D, SSQ};
            pg8::gemm_phase<pg8::EpiY, pg8::StaticOrder, true, true>(lds, g, So, E);
        }
        GSYNC(); } } if (l == 0) STAMP(6);
        if (PH(15)) {
            const float* mf = MODS + (size_t)(2 * l + 1) * 8 * 3072;
            if (l == 0) {
                const float* mm1 = MODS + (size_t)2 * 8 * 3072; const float* mkv = MODS + (size_t)4 * 8 * 3072;
                thin_pass<true, 2, false, true, true>(gw, NGW, lane, X1, X2, Y, SSQ, norm_post_ffn, mf + 2048,
                                   norm_pre_mix + D, mm1 + 1024, mm1, Hb, kv_norm, mkv + 1024, mkv, (bf16_t*)(R + 128 * MiB));
                GSYNC();
            } else {
                thin_pass<true, 0, false, true, false>(gw, NGW, lane, X3, out, Y, SSQ, norm_post_ffn + D, mf + 2048,
                                   nullptr, nullptr, nullptr, nullptr, nullptr, nullptr, nullptr, nullptr);
            }
        }
    }
#ifdef PROBE_R
    GSYNC(); STAMP(10); GSYNC();
    {
        const volatile unsigned long long* ts = (const volatile unsigned long long*)(a.ws + 520192);
        const int ga = 2 * PROBE_R + 1, gb = 2 * PROBE_R + 2;
        const float tA = (float)(ts[ga] - ts[ga - 1]) * 0.01f, tB = (float)(ts[gb] - ts[gb - 1]) * 0.01f;
        if (bx == 0 && tid == 0) out[0] += tA;
        for (int i = bx * 512 + tid; i < (1 << 20); i += G * 512) out[1024 + i] += tB * (1.0f / 16.0f);
    }
#endif
}

extern "C" void kernel_launch(void* const* d_in, const int* in_sizes, int n_in, void* d_out, int out_size, void* d_ws, size_t ws_size, hipStream_t stream) {
    static int grid = 0;
    if (grid == 0) {
        if (n_in != 30 || out_size != M * D || ws_size < WS_END) { fprintf(stderr, "kernel_launch: unexpected shapes (n_in %d out %d ws %zu)\n", n_in, out_size, ws_size); grid = -1; return; }
        int dev = 0, cus = 0, per_cu = 0;
        (void)hipGetDevice(&dev);
        (void)hipDeviceGetAttribute(&cus, hipDeviceAttributeMultiprocessorCount, dev);
        (void)hipFuncSetAttribute((const void*)mk_fwd, hipFuncAttributeMaxDynamicSharedMemorySize, LDS_BYTES);
        (void)hipOccupancyMaxActiveBlocksPerMultiprocessor(&per_cu, (const void*)mk_fwd, 512, LDS_BYTES);
        if (per_cu < 1) per_cu = 1;
        grid = cus * per_cu;
    }
    if (grid < 0) return;
    Args a{};
    for (int i = 0; i < 30; ++i) a.in[i] = d_in[i];
    a.out = (float*)d_out; a.ws = (unsigned char*)d_ws;
    void* args[] = {&a};
    hipError_t e = hipLaunchCooperativeKernel((const void*)mk_fwd, dim3(grid), dim3(512), args, LDS_BYTES, stream);
    if (e != hipSuccess) fprintf(stderr, "cooperative launch failed: %s (grid %d)\n", hipGetErrorString(e), grid);
}
```
